# Optimizing an MI355X kernel written in HIP

```python
import jax, jax.numpy as jnp
from jax import lax
import numpy as np

D_MODEL = 1024
BATCH = 8
SEQ = 4096
DEPTH = 2

LRU_WIDTH = D_MODEL
LRU_HEADS = 8
LRU_HEAD_DIM = LRU_WIDTH // LRU_HEADS
LRU_C = 8.0
CONV_WIDTH = 4
DN_HEADS = 8
DN_HEAD_K = 128
DN_HEAD_V = 128
DN_KEY_DIM = DN_HEADS * DN_HEAD_K
DN_VALUE_DIM = DN_HEADS * DN_HEAD_V
DN_CONV_DIM = 2 * DN_KEY_DIM + DN_VALUE_DIM
CHUNK = 64
D_MIX = LRU_WIDTH + DN_VALUE_DIM
D_IN = 2 * LRU_WIDTH + DN_CONV_DIM + DN_VALUE_DIM + 2 * DN_HEADS
SPLITS = [LRU_WIDTH, 2 * LRU_WIDTH, 2 * LRU_WIDTH + DN_CONV_DIM,
          2 * LRU_WIDTH + DN_CONV_DIM + DN_VALUE_DIM,
          2 * LRU_WIDTH + DN_CONV_DIM + DN_VALUE_DIM + DN_HEADS]
EPS = 1e-6

kernel_name = "hymba_rglru_gated_deltanet_trunk"


def rmsnorm(x, w):
    xf = x.astype(jnp.float32)
    y = xf * lax.rsqrt(jnp.mean(xf * xf, axis=-1, keepdims=True) + EPS)
    return (y * w.astype(jnp.float32)).astype(x.dtype)


def gated_rmsnorm(o, z, w):
    of = o.astype(jnp.float32)
    y = of * lax.rsqrt(jnp.mean(of * of, axis=-1, keepdims=True) + EPS)
    return (y * w.astype(jnp.float32) * jax.nn.silu(z.astype(jnp.float32))).astype(o.dtype)


def l2norm(x):
    return x * lax.rsqrt(jnp.sum(x * x, axis=-1, keepdims=True) + EPS)


def causal_dwconv(x, w):
    K = w.shape[0]
    S = x.shape[1]
    xp = jnp.pad(x, ((0, 0), (K - 1, 0), (0, 0)))
    y = xp[:, 0:S] * w[0]
    for j in range(1, K):
        y = y + xp[:, j:j + S] * w[j]
    return y


def rg_lru(x, wa, ba, wx, bx, lam):
    B_, S_, W = x.shape
    xh = x.reshape(B_, S_, LRU_HEADS, LRU_HEAD_DIM)
    r = jax.nn.sigmoid(jnp.einsum('bshi,hij->bshj', xh, wa).reshape(B_, S_, W) + ba)
    i = jax.nn.sigmoid(jnp.einsum('bshi,hij->bshj', xh, wx).reshape(B_, S_, W) + bx)
    log_a = -LRU_C * r * jax.nn.softplus(-lam)
    a = jnp.exp(log_a)
    mult = jnp.sqrt(-jnp.expm1(2.0 * log_a))
    b = mult * (i * x)

    def combine(left, right):
        a_l, b_l = left
        a_r, b_r = right
        return a_l * a_r, a_r * b_l + b_r

    _, h = lax.associative_scan(combine, (a, b), axis=1)
    return h


def gated_delta_rule(q, k, v, g, beta):
    B_, S_, H, dk = q.shape
    dv = v.shape[-1]
    N = S_ // CHUNK

    def to_chunks(t):
        return t.reshape(B_, N, CHUNK, H, t.shape[-1]).transpose(0, 3, 1, 2, 4)

    q, k, v = to_chunks(q), to_chunks(k), to_chunks(v)
    g = g.reshape(B_, N, CHUNK, H).transpose(0, 3, 1, 2)
    beta = beta.reshape(B_, N, CHUNK, H).transpose(0, 3, 1, 2)
    k_beta = k * beta[..., None]
    v_beta = v * beta[..., None]
    gc = jnp.cumsum(g, axis=-1)
    tri = jnp.tril(jnp.ones((CHUNK, CHUNK), dtype=bool))
    strict = jnp.tril(jnp.ones((CHUNK, CHUNK), dtype=bool), -1)
    decay_mask = jnp.exp(jnp.where(tri, gc[..., :, None] - gc[..., None, :], -jnp.inf))
    A = jnp.where(strict, jnp.einsum('bhncd,bhnjd->bhncj', k_beta, k) * decay_mask, 0.0)
    T = A + jnp.eye(CHUNK, dtype=A.dtype)
    u = lax.linalg.triangular_solve(T, v_beta, left_side=True, lower=True, unit_diagonal=True)
    w = lax.linalg.triangular_solve(T, k_beta * jnp.exp(gc)[..., None],
                                    left_side=True, lower=True, unit_diagonal=True)
    attn = jnp.where(tri, jnp.einsum('bhncd,bhnjd->bhncj', q, k) * decay_mask, 0.0)

    def step(state, xs):
        q_i, k_i, u_i, w_i, attn_i, gc_i = xs
        v_new = u_i - jnp.einsum('bhcd,bhde->bhce', w_i, state)
        o_i = (jnp.einsum('bhcd,bhde->bhce', q_i * jnp.exp(gc_i)[..., None], state)
               + jnp.einsum('bhcj,bhje->bhce', attn_i, v_new))
        g_last = gc_i[..., -1]
        state = (state * jnp.exp(g_last)[..., None, None]
                 + jnp.einsum('bhcd,bhce->bhde', k_i * jnp.exp(g_last[..., None] - gc_i)[..., None], v_new))
        return state, o_i

    xs = tuple(jnp.moveaxis(t, 2, 0) for t in (q, k, u, w, attn, gc))
    state0 = jnp.zeros((B_, H, dk, dv), dtype=q.dtype)
    _, o = lax.scan(step, state0, xs)
    return o.transpose(1, 0, 3, 2, 4).reshape(B_, S_, H, dv)


def hybrid_layer(x, norm_w, w_in, lru_conv_w, lru_conv_b, lru_wa, lru_ba, lru_wx, lru_bx,
                 lru_lambda, lru_norm_w, dn_conv_w, dn_A_log, dn_dt_bias, dn_norm_w, w_out):
    B_, S_, _ = x.shape
    f32 = jnp.float32
    h = rmsnorm(x, norm_w)
    proj = jnp.einsum('bsd,de->bse', h, w_in)
    lru_x, lru_z, dn_qkv, dn_z, dn_b, dn_a = jnp.split(proj, SPLITS, axis=-1)

    xc = (causal_dwconv(lru_x, lru_conv_w) + lru_conv_b).astype(f32)
    hl = rg_lru(xc, lru_wa.astype(f32), lru_ba.astype(f32), lru_wx.astype(f32),
                lru_bx.astype(f32), lru_lambda.astype(f32))
    y_lru = gated_rmsnorm(hl.reshape(B_, S_, LRU_HEADS, LRU_HEAD_DIM),
                          lru_z.reshape(B_, S_, LRU_HEADS, LRU_HEAD_DIM),
                          lru_norm_w.reshape(LRU_HEADS, LRU_HEAD_DIM))

    qkv = jax.nn.silu(causal_dwconv(dn_qkv, dn_conv_w)).astype(f32)
    q, k, v = jnp.split(qkv, [DN_KEY_DIM, 2 * DN_KEY_DIM], axis=-1)
    q = l2norm(q.reshape(B_, S_, DN_HEADS, DN_HEAD_K)) * (DN_HEAD_K ** -0.5)
    k = l2norm(k.reshape(B_, S_, DN_HEADS, DN_HEAD_K))
    v = v.reshape(B_, S_, DN_HEADS, DN_HEAD_V)
    beta = jax.nn.sigmoid(dn_b.astype(f32))
    g = -jnp.exp(dn_A_log.astype(f32)) * jax.nn.softplus(dn_a.astype(f32) + dn_dt_bias.astype(f32))
    o = gated_delta_rule(q, k, v, g, beta)
    y_dn = gated_rmsnorm(o, dn_z.reshape(B_, S_, DN_HEADS, DN_HEAD_V), dn_norm_w)

    y = jnp.concatenate([y_lru.reshape(B_, S_, LRU_WIDTH), y_dn.reshape(B_, S_, DN_VALUE_DIM)],
                        axis=-1).astype(x.dtype)
    return x + jnp.einsum('bse,ed->bsd', y, w_out).astype(x.dtype)


def setup_inputs(seed: int = 0) -> dict:
    key = jax.random.key(seed)
    ks = jax.random.split(key, 20)
    nrm = jax.random.normal
    L = DEPTH
    x = nrm(ks[0], (BATCH, SEQ, D_MODEL), jnp.float32)
    norm_w = 1.0 + 0.01 * nrm(ks[1], (L, D_MODEL), jnp.float32)
    w_in = nrm(ks[2], (L, D_MODEL, D_IN), jnp.float32) * D_MODEL ** -0.5
    lru_conv_w = nrm(ks[3], (L, CONV_WIDTH, LRU_WIDTH), jnp.float32) * CONV_WIDTH ** -0.5
    lru_conv_b = 0.01 * nrm(ks[4], (L, LRU_WIDTH), jnp.float32)
    lru_wa = nrm(ks[5], (L, LRU_HEADS, LRU_HEAD_DIM, LRU_HEAD_DIM), jnp.float32) * LRU_HEAD_DIM ** -0.5
    lru_ba = 0.01 * nrm(ks[6], (L, LRU_WIDTH), jnp.float32)
    lru_wx = nrm(ks[7], (L, LRU_HEADS, LRU_HEAD_DIM, LRU_HEAD_DIM), jnp.float32) * LRU_HEAD_DIM ** -0.5
    lru_bx = 0.01 * nrm(ks[8], (L, LRU_WIDTH), jnp.float32)
    a0 = jax.random.uniform(ks[9], (L, LRU_WIDTH), jnp.float32, 0.9, 0.999)
    s = a0 ** (1.0 / LRU_C)
    lru_lambda = jnp.log(s) - jnp.log1p(-s)
    lru_norm_w = 1.0 + 0.01 * nrm(ks[10], (L, LRU_WIDTH), jnp.float32)
    dn_conv_w = nrm(ks[11], (L, CONV_WIDTH, DN_CONV_DIM), jnp.float32) * CONV_WIDTH ** -0.5
    dn_A_log = jnp.log(jax.random.uniform(ks[12], (L, DN_HEADS), jnp.float32, 1.0, 16.0))
    dt = jnp.exp(jax.random.uniform(ks[13], (L, DN_HEADS), jnp.float32,
                                    float(np.log(1e-3)), float(np.log(1e-1))))
    dn_dt_bias = dt + jnp.log(-jnp.expm1(-dt))
    dn_norm_w = 1.0 + 0.01 * nrm(ks[14], (L, DN_HEAD_V), jnp.float32)
    w_out = nrm(ks[15], (L, D_MIX, D_MODEL), jnp.float32) * D_MIX ** -0.5
    final_norm_w = 1.0 + 0.01 * nrm(ks[16], (D_MODEL,), jnp.float32)
    return {"x": x, "norm_w": norm_w, "w_in": w_in, "lru_conv_w": lru_conv_w,
            "lru_conv_b": lru_conv_b, "lru_wa": lru_wa, "lru_ba": lru_ba, "lru_wx": lru_wx,
            "lru_bx": lru_bx, "lru_lambda": lru_lambda, "lru_norm_w": lru_norm_w,
            "dn_conv_w": dn_conv_w, "dn_A_log": dn_A_log, "dn_dt_bias": dn_dt_bias,
            "dn_norm_w": dn_norm_w, "w_out": w_out, "final_norm_w": final_norm_w}


def reference(x, norm_w, w_in, lru_conv_w, lru_conv_b, lru_wa, lru_ba, lru_wx, lru_bx,
              lru_lambda, lru_norm_w, dn_conv_w, dn_A_log, dn_dt_bias, dn_norm_w, w_out,
              final_norm_w):
    h = x
    for l in range(DEPTH):
        h = hybrid_layer(h, norm_w[l], w_in[l], lru_conv_w[l], lru_conv_b[l], lru_wa[l], lru_ba[l],
                         lru_wx[l], lru_bx[l], lru_lambda[l], lru_norm_w[l], dn_conv_w[l],
                         dn_A_log[l], dn_dt_bias[l], dn_norm_w[l], w_out[l])
    return rmsnorm(h, final_norm_w)
```

```cpp
#include <hip/hip_runtime.h>
#include <hip/hip_cooperative_groups.h>
#include <cstdio>
namespace cg = cooperative_groups;
#ifndef MK_SINGLE
#define MK_SINGLE 1
#endif
namespace pg8 {
#define PG8_LAS __attribute__((address_space(3)))
typedef unsigned short bf16_t;
typedef short bf16x8 __attribute__((ext_vector_type(8)));
typedef float f32x4 __attribute__((ext_vector_type(4)));
typedef unsigned u32x4 __attribute__((ext_vector_type(4)));
constexpr int BM = 256, BK = 64, HALF = 128, HTB = HALF * BK * 2  , STAGE_BYTES = 8 * HTB, NXCD = 8, WGM = 8;

__host__ __device__ __forceinline__ int lds_byte(int r, int c) { const int st = (r >> 4) * 2 + (c >> 5), rr = r & 15, cc = c & 31, ob = rr * 64 + cc * 2; return st * 1024 + (ob ^ (((ob >> 9) & 1) << 5)); }
__host__ __device__ __forceinline__ void stage_rc(int b, int& R, int& C) { const int st = b / 1024, sb = b % 1024, swz = sb ^ (((sb >> 9) & 1) << 5); R = (st >> 1) * 16 + swz / 64; C = (st & 1) * 32 + (swz % 64) / 2; }
__host__ __device__ __forceinline__ int perm32(int rho) { const int n = rho >> 4, i = rho & 15; return 8 * (i >> 2) + 4 * n + (i & 3); }

struct Unit { int pm, pn; };
struct Gemm { const bf16_t* A; const bf16_t* Bt; int M, N, K; };

struct StaticOrder {
    int nM, nN, nwg, G, c;
    __host__ __device__ void init(int M, int N, int G_, int c_) { nM = M / BM; nN = N / BM; nwg = nM * nN; G = G_; c = c_; }
    __host__ __device__ bool next(int i, Unit& u) const {
        const long L = (long)i * G + c; if (L >= nwg) return false;
        int wgid = (int)L; { const int q = nwg / NXCD, r = nwg % NXCD, xcd = wgid % NXCD, off = wgid / NXCD; wgid = (xcd < r ? xcd * (q + 1) : r * (q + 1) + (xcd - r) * q) + off; }
        const int nig = WGM * nN, gid = wgid / nig, fm = gid * WGM, gsz = (nM - fm) < WGM ? (nM - fm) : WGM;
        u.pm = fm + ((wgid % nig) % gsz); u.pn = (wgid % nig) / gsz; return true;
    }
    __device__ __forceinline__ void a_ready(const Unit&) const {}
    __device__ __forceinline__ void done(const Unit&) const {}
};
__device__ __forceinline__ unsigned cvt_pk_bf16(float lo, float hi) { unsigned r; asm volatile("v_cvt_pk_bf16_f32 %0, %1, %2" : "=v"(r) : "v"(lo), "v"(hi)); return r; }
template <class Epi, class Sched, bool STAMP = false>
__device__ __forceinline__ void gemm_phase(PG8_LAS unsigned char* lds, const Gemm g, const Sched& S, const Epi& E, unsigned long long* stamps) {
    int tid_ = threadIdx.x; asm volatile("" : "+v"(tid_)); const int tid = tid_, wid = __builtin_amdgcn_readfirstlane(tid >> 6), lane = tid & 63, wr = wid >> 2, wc = wid & 3, fr = lane & 15, fq = lane >> 4;
    const int K = g.K, nt = K / BK;
    int ts_lo = 0, ts_hi = 0, nts = 0; const unsigned long long rt_entry = STAMP ? (unsigned long long)wall_clock64() : 0ull;
#define PG8_STAMP() do { if (STAMP && wid == 0 && nts < 64) { const unsigned long long _c = (unsigned long long)clock64(); \
        ts_lo = (lane == nts) ? (int)(unsigned)_c : ts_lo; ts_hi = (lane == nts) ? (int)(unsigned)(_c >> 32) : ts_hi; ++nts; } } while (0)
    PG8_STAMP();
    unsigned voffA[2], voffB[2];
#pragma unroll
    for (int i = 0; i < 2; ++i) { int R, C; stage_rc(tid * 16 + i * 8192, R, C); const int Rb = Epi::PERM ? ((R & ~31) + perm32(R & 31)) : R;
        voffA[i] = (unsigned)(R * K + C) * 2u; voffB[i] = (unsigned)(Rb * K + C) * 2u; }
    const size_t kstep = (size_t)(BK * 2);
    const size_t hstep = (size_t)HALF * K * 2;
    const size_t tstep = 2 * hstep;
    const unsigned ldsw = (unsigned)wid * 1024u;
    const int aoff = lds_byte(wr * 64 + fr, fq * 8), boff = lds_byte(wc * 32 + fr, fq * 8);
#define PG8_SA(b, h) (((b) * 2 + (h)) * HTB)
#define PG8_SB(b, h) ((4 + (b) * 2 + (h)) * HTB)
#define PG8_STAGE(bufoff, gbase, voff) do { _Pragma("unroll") for (int _i = 0; _i < 2; ++_i) \
        __builtin_amdgcn_global_load_lds((const unsigned*)((const char*)(gbase) + (voff)[_i]), (PG8_LAS unsigned*)(lds + (bufoff) + ldsw + _i * 8192), 16, 0, 0); } while (0)
#define PG8_LDA(dst, b, h) do { _Pragma("unroll") for (int m = 0; m < 4; ++m) _Pragma("unroll") for (int k = 0; k < 2; ++k) dst[m][k] = *(const PG8_LAS bf16x8*)(lds + PG8_SA(b, h) + aoff + m * 2048 + k * 1024); } while (0)
#define PG8_LDB(dst, b, h) do { _Pragma("unroll") for (int n = 0; n < 2; ++n) _Pragma("unroll") for (int k = 0; k < 2; ++k) dst[n][k] = *(const PG8_LAS bf16x8*)(lds + PG8_SB(b, h) + boff + n * 2048 + k * 1024); } while (0)
#define PG8_MMA(ai, bj, At, Bt) do { __builtin_amdgcn_s_setprio(1); _Pragma("unroll") for (int m = 0; m < 4; ++m) _Pragma("unroll") for (int n = 0; n < 2; ++n) _Pragma("unroll") for (int k = 0; k < 2; ++k) \
        acc[ai][bj][m][n] = __builtin_amdgcn_mfma_f32_16x16x32_bf16(Bt[n][k], At[m][k], acc[ai][bj][m][n], 0, 0, 0); __builtin_amdgcn_s_setprio(0); } while (0)
#define PG8_WAIT_V(n) asm volatile("s_waitcnt vmcnt(" #n ")" ::: "memory")
#define PG8_WAIT_L(n) asm volatile("s_waitcnt lgkmcnt(" #n ")" ::: "memory")
#define PG8_BAR __builtin_amdgcn_s_barrier()
#define PG8_SCHED __builtin_amdgcn_sched_barrier(0)
    Unit cur, nxt; int ui = 0;
    if (!S.next(0, cur)) return;
    f32x4 acc[2][2][4][2];
#pragma unroll
    for (int a = 0; a < 2; ++a)
#pragma unroll
        for (int b = 0; b < 2; ++b)
#pragma unroll
            for (int m = 0; m < 4; ++m)
#pragma unroll
                for (int n = 0; n < 2; ++n) acc[a][b][m][n] = (f32x4){0.f, 0.f, 0.f, 0.f};
    bf16x8 At[4][2], B0[2][2], B1[2][2];
    const char* cA = (const char*)g.A + (size_t)cur.pm * tstep; const char* cB = (const char*)g.Bt + (size_t)cur.pn * tstep;
    S.a_ready(cur);
    PG8_STAGE(PG8_SB(0, 0), cB, voffB); PG8_STAGE(PG8_SA(0, 0), cA, voffA); PG8_STAGE(PG8_SB(0, 1), cB + hstep, voffB); PG8_STAGE(PG8_SA(0, 1), cA + hstep, voffA);
    if (wr == 1) PG8_BAR;
    PG8_WAIT_V(4); PG8_BAR;
    PG8_STAGE(PG8_SB(1, 0), cB + kstep, voffB); PG8_STAGE(PG8_SA(1, 0), cA + kstep, voffA); PG8_STAGE(PG8_SB(1, 1), cB + hstep + kstep, voffB);
    PG8_WAIT_V(6); PG8_BAR;
    PG8_STAMP();
    for (;;) {
        const bool has_next = S.next(ui + 1, nxt);
        const char* nA = has_next ? (const char*)g.A + (size_t)nxt.pm * tstep : cA; const char* nB = has_next ? (const char*)g.Bt + (size_t)nxt.pn * tstep : cB;
        for (int t = 0; t < nt; t += 2) {
            const bool last = (t == nt - 2);
            const char* a1 = cA + (size_t)(t + 1) * kstep;
            const char* a2 = last ? nA : cA + (size_t)(t + 2) * kstep; const char* b2 = last ? nB : cB + (size_t)(t + 2) * kstep;
            const char* a3 = a2 + kstep; const char* b3 = b2 + kstep;
            if (last && has_next) S.a_ready(nxt);
            PG8_LDB(B0, 0, 0); PG8_SCHED; PG8_LDA(At, 0, 0); PG8_STAGE(PG8_SA(1, 1), a1 + hstep, voffA);
            PG8_WAIT_L(8); PG8_BAR; PG8_WAIT_L(0); PG8_MMA(0, 0, At, B0); PG8_BAR; PG8_SCHED;
            PG8_LDB(B1, 0, 1); PG8_STAGE(PG8_SB(0, 0), b2, voffB);
            PG8_BAR; PG8_WAIT_L(0); PG8_MMA(0, 1, At, B1); PG8_BAR;
            PG8_LDA(At, 0, 1); PG8_STAGE(PG8_SA(0, 0), a2, voffA);
            PG8_BAR; PG8_WAIT_L(0); PG8_MMA(1, 0, At, B0); PG8_BAR; PG8_SCHED;
            PG8_STAGE(PG8_SB(0, 1), b2 + hstep, voffB);
            PG8_WAIT_V(6); PG8_BAR; PG8_MMA(1, 1, At, B1); PG8_BAR;
            PG8_LDB(B0, 1, 0); PG8_SCHED; PG8_LDA(At, 1, 0); PG8_STAGE(PG8_SA(0, 1), a2 + hstep, voffA);
            PG8_WAIT_L(8); PG8_BAR; PG8_WAIT_L(0); PG8_MMA(0, 0, At, B0); PG8_BAR; PG8_SCHED;
            PG8_LDB(B1, 1, 1); PG8_STAGE(PG8_SB(1, 0), b3, voffB);
            PG8_BAR; PG8_WAIT_L(0); PG8_MMA(0, 1, At, B1); PG8_BAR;
            PG8_LDA(At, 1, 1); PG8_STAGE(PG8_SA(1, 0), a3, voffA);
            PG8_BAR; PG8_WAIT_L(0); PG8_MMA(1, 0, At, B0); PG8_BAR; PG8_SCHED;
            PG8_STAGE(PG8_SB(1, 1), b3 + hstep, voffB);
            PG8_WAIT_V(6); PG8_BAR; PG8_MMA(1, 1, At, B1); PG8_BAR;
        }
        PG8_STAMP();
        if constexpr (!Epi::AFTER_DRAIN) { E(acc, cur, wr, wc, fr, fq); S.done(cur); }
        PG8_STAMP();
        if (!has_next) break;
#pragma unroll
        for (int a = 0; a < 2; ++a)
#pragma unroll
            for (int b = 0; b < 2; ++b)
#pragma unroll
                for (int m = 0; m < 4; ++m)
#pragma unroll
                    for (int n = 0; n < 2; ++n) acc[a][b][m][n] = (f32x4){0.f, 0.f, 0.f, 0.f};
        cur = nxt; cA = nA; cB = nB; ++ui;
    }
    PG8_WAIT_V(0);
    if (wr == 0) PG8_BAR;
    PG8_BAR;
    if constexpr (Epi::AFTER_DRAIN) { E.fused(acc, cur, wr, wc, fr, fq, lds, wid, lane); S.done(cur); }
    PG8_STAMP();
    if (STAMP && wid == 0) { stamps[lane] = lane < nts ? (((unsigned long long)(unsigned)ts_hi << 32) | (unsigned)ts_lo) : 0ull;
        if (lane == 62) stamps[62] = rt_entry; if (lane == 63) stamps[63] = (unsigned long long)wall_clock64(); }
#undef PG8_STAMP
#undef PG8_SA
#undef PG8_SB
#undef PG8_STAGE
#undef PG8_LDA
#undef PG8_LDB
#undef PG8_MMA
#undef PG8_WAIT_V
#undef PG8_WAIT_L
#undef PG8_BAR
#undef PG8_SCHED
}
}

using pg8::bf16_t; using pg8::bf16x8; using pg8::f32x4; using pg8::u32x4;
typedef unsigned u32x2 __attribute__((ext_vector_type(2)));
#define DI __device__ __forceinline__
#define MFMA16(a, b, c) __builtin_amdgcn_mfma_f32_16x16x32_bf16((a), (b), (c), 0, 0, 0)

constexpr int D_ = 1024, SEQ_ = 4096, M_ = 32768, DIN_ = 6160, NPAD_ = 6400;
constexpr size_t PLANE_ = (size_t)M_ * 1024;
constexpr size_t OFF_WIN = 0;
constexpr size_t OFF_WOUT = OFF_WIN + (size_t)2 * NPAD_ * 1024 * 2;
constexpr size_t OFF_WG = OFF_WOUT + (size_t)2 * 1024 * 2048 * 2;
constexpr size_t OFF_XB = OFF_WG + (size_t)2 * 8 * 256 * 128 * 2;
constexpr size_t OFF_LRUX = OFF_XB + PLANE_ * 2;
constexpr size_t OFF_ZY = OFF_LRUX + PLANE_ * 2;
constexpr size_t OFF_QKV = OFF_ZY + PLANE_ * 4;
constexpr size_t OFF_HALO = OFF_QKV + PLANE_ * 6;
constexpr size_t OFF_BA = OFF_HALO + (size_t)3 * 4096 * 3 * 128 * 2;
constexpr size_t OFF_RSTD = OFF_BA + (size_t)M_ * 16 * 4;
constexpr size_t OFF_G = OFF_RSTD + (size_t)M_ * 4;
constexpr size_t OFF_GC = OFF_G + (size_t)M_ * 8 * 4;
constexpr size_t OFF_BETA = OFF_GC + (size_t)M_ * 8 * 4;
constexpr size_t OFF_AGG = OFF_BETA + (size_t)M_ * 8 * 4;
constexpr size_t WS_END = OFF_AGG + (size_t)8 * 64 * 1024 * 2 * 4;
constexpr int LDS_BYTES = 131072;
constexpr int N_PHASES = 11;

struct Params {
    const float *x, *norm_w, *w_in, *lru_conv_w, *lru_conv_b, *lru_wa, *lru_ba, *lru_wx, *lru_bx, *lru_lambda, *lru_norm_w,
        *dn_conv_w, *dn_A_log, *dn_dt_bias, *dn_norm_w, *w_out, *final_norm_w;
    float* out;
    unsigned char* ws;
    int ph_lo, ph_hi;
};

DI int otid() { int t = threadIdx.x; asm volatile("" : "+v"(t)); return t; }
DI bf16_t f2bf(float f) { unsigned u = __float_as_uint(f); u += 0x7FFFu + ((u >> 16) & 1u); return (bf16_t)(u >> 16); }
DI float bf2f(bf16_t b) { return __uint_as_float(((unsigned)b) << 16); }
DI unsigned pk2(float lo, float hi) { return (unsigned)f2bf(lo) | ((unsigned)f2bf(hi) << 16); }
DI float sigmoidf_(float x) { return 1.f / (1.f + __expf(-x)); }
DI float softplusf_(float x) { return x > 20.f ? x : log1pf(__expf(x)); }
DI void unpack8(const u32x4 v, float* o) {
#pragma unroll
    for (int i = 0; i < 4; ++i) { o[2 * i] = __uint_as_float(v[i] << 16); o[2 * i + 1] = __uint_as_float(v[i] & 0xFFFF0000u); }
}

struct EpiIn {
    static constexpr bool PERM = true, AFTER_DRAIN = false;
    const float* rstd; unsigned char* ws;
    DI void operator()(const f32x4 (&acc)[2][2][4][2], const pg8::Unit& u, int wr, int wc, int fr, int fq) const {
        const int row0 = u.pm * 256 + wr * 64 + fr;
        const int pn = u.pn;
        const float* rs = rstd + row0;
        if (pn == 24) {
            if (wc == 0 && fq < 2) {
                float* ba = (float*)(ws + OFF_BA) + (size_t)row0 * 16 + 8 * fq;
#pragma unroll
                for (int ai = 0; ai < 2; ++ai)
#pragma unroll
                    for (int m = 0; m < 4; ++m) {
                        const float s = rs[ai * 128 + m * 16];
#pragma unroll
                        for (int n = 0; n < 2; ++n) { f32x4 v = acc[ai][0][m][n] * s; *(f32x4*)(ba + (size_t)(ai * 128 + m * 16) * 16 + 4 * n) = v; }
                    }
            }
            return;
        }
        const int region = pn >> 2;
        const int colr = (pn & 3) * 256 + wc * 32 + 8 * fq;
        bf16_t* base; int SA, SB, SM; bf16_t* hbase = nullptr;
        if (region == 0) { base = (bf16_t*)(ws + OFF_LRUX) + (size_t)row0 * 1024 + colr; SA = 128 * 1024; SB = 128; SM = 16 * 1024; }
        else if (region == 1 || region == 5) { base = (bf16_t*)(ws + OFF_ZY) + (size_t)row0 * 2048 + colr + (region == 5 ? 1024 : 0); SA = 128 * 2048; SB = 128; SM = 16 * 2048; }
        else {
            const int pl = region - 2, h0 = (pn & 3) * 2, d = wc * 32 + 8 * fq, b = u.pm >> 4, n0 = (u.pm * 4 + wr) & 63;
            const int blk = (b * 8 + h0) * 64 + n0;
            base = (bf16_t*)(ws + OFF_QKV) + (size_t)pl * PLANE_ + ((size_t)blk * 64 + fr) * 128 + d; SA = 2 * 8192; SB = 64 * 8192; SM = 16 * 128;
            hbase = (bf16_t*)(ws + OFF_HALO) + (((size_t)pl * 4096 + blk) * 3 + (fr - 13)) * 128 + d;
        }
#pragma unroll
        for (int ai = 0; ai < 2; ++ai)
#pragma unroll
            for (int m = 0; m < 4; ++m) {
                const float s = rs[ai * 128 + m * 16];
#pragma unroll
                for (int bj = 0; bj < 2; ++bj) {
                    const f32x4 v0 = acc[ai][bj][m][0] * s, v1 = acc[ai][bj][m][1] * s;
                    u32x4 w; w[0] = pg8::cvt_pk_bf16(v0[0], v0[1]); w[1] = pg8::cvt_pk_bf16(v0[2], v0[3]); w[2] = pg8::cvt_pk_bf16(v1[0], v1[1]); w[3] = pg8::cvt_pk_bf16(v1[2], v1[3]);
                    *(u32x4*)(base + (size_t)ai * SA + (size_t)bj * SB + (size_t)m * SM) = w;
                    if (m == 3 && hbase != nullptr && fr >= 13) *(u32x4*)(hbase + ai * (2 * 384) + bj * (64 * 384)) = w;
                }
                asm volatile("" ::: "memory");
            }
    }
};
struct EpiOut {
    static constexpr bool PERM = false, AFTER_DRAIN = false;
    const float* res; float* out;
    DI void operator()(const f32x4 (&acc)[2][2][4][2], const pg8::Unit& u, int wr, int wc, int fr, int fq) const {
        const int row0 = u.pm * 256 + wr * 64 + fr, col0 = u.pn * 256 + wc * 32 + 4 * fq;
#pragma unroll
        for (int ai = 0; ai < 2; ++ai)
#pragma unroll
            for (int m = 0; m < 4; ++m) {
                const size_t ro = (size_t)(row0 + ai * 128 + m * 16) * 1024 + col0;
#pragma unroll
                for (int bj = 0; bj < 2; ++bj)
#pragma unroll
                    for (int n = 0; n < 2; ++n) { const f32x4 rv = *(const f32x4*)(res + ro + bj * 128 + n * 16); *(f32x4*)(out + ro + bj * 128 + n * 16) = rv + acc[ai][bj][m][n]; }
            }
    }
};

DI void transpose_tile(const float* src, int src_ld, int C, const float* scale, bf16_t* dst, int dst_ld, int r0, int c0, float* lds) {
    const int tid = otid();
    for (int e = tid; e < 4096; e += 512) {
        const int rr = e >> 6, cc = e & 63; float v = 0.f;
        if (c0 + cc < C) { v = src[(size_t)(r0 + rr) * src_ld + c0 + cc]; if (scale) v *= scale[r0 + rr]; }
        lds[rr * 65 + cc] = v;
    }
    __syncthreads();
    for (int e = tid; e < 4096; e += 512) { const int cc = e >> 6, rr = e & 63; dst[(size_t)(c0 + cc) * dst_ld + r0 + rr] = f2bf(lds[rr * 65 + cc]); }
    __syncthreads();
}
DI void prep_phase(const Params& p, unsigned char* shm) {
    bf16_t* WinT = (bf16_t*)(p.ws + OFF_WIN); bf16_t* WoutT = (bf16_t*)(p.ws + OFF_WOUT); bf16_t* WgT = (bf16_t*)(p.ws + OFF_WG);
    float* lds = (float*)shm;
    for (int idx = blockIdx.x; idx < 4352; idx += gridDim.x) {
        if (idx < 3200) {
            const int l = idx / 1600, t = idx % 1600, rt = t / 100, ct = t % 100;
            transpose_tile(p.w_in + (size_t)l * 1024 * DIN_, DIN_, DIN_, p.norm_w + l * 1024, WinT + (size_t)l * NPAD_ * 1024, 1024, rt * 64, ct * 64, lds);
        } else if (idx < 4224) {
            const int j = idx - 3200, l = j / 512, t = j % 512, rt = t / 16, ct = t % 16;
            transpose_tile(p.w_out + (size_t)l * 2048 * 1024, 1024, 1024, nullptr, WoutT + (size_t)l * 1024 * 2048, 2048, rt * 64, ct * 64, lds);
        } else {
            const int j = idx - 4224, l = j / 64, g = (j / 32) & 1, h = (j / 4) & 7, tt = j & 3, rt = tt >> 1, ct = tt & 1;
            const float* src = (g ? p.lru_wx : p.lru_wa) + (size_t)(l * 8 + h) * 128 * 128;
            transpose_tile(src, 128, 128, nullptr, WgT + ((size_t)(l * 8 + h) * 256 + g * 128) * 128, 128, rt * 64, ct * 64, lds);
        }
    }
}
DI void rownorm_phase(const float* src, bf16_t* xb, float* rstd, const float* fw, float* dst) {
    const int tid = otid(); const int lane = tid & 63, wave = blockIdx.x * 8 + (tid >> 6), nw = gridDim.x * 8;
    for (int row = wave; row < M_; row += nw) {
        const float4* sp = (const float4*)(src + (size_t)row * 1024);
        float4 v[4]; float ss = 0.f;
#pragma unroll
        for (int i = 0; i < 4; ++i) { v[i] = sp[lane + 64 * i]; ss += v[i].x * v[i].x + v[i].y * v[i].y + v[i].z * v[i].z + v[i].w * v[i].w; }
#pragma unroll
        for (int o = 32; o >= 1; o >>= 1) ss += __shfl_xor(ss, o);
        const float r = rsqrtf(ss * (1.f / 1024.f) + 1e-6f);
        if (fw) {
#pragma unroll
            for (int i = 0; i < 4; ++i) { const float4 w4 = ((const float4*)fw)[lane + 64 * i]; float4 o4; o4.x = v[i].x * r * w4.x; o4.y = v[i].y * r * w4.y; o4.z = v[i].z * r * w4.z; o4.w = v[i].w * r * w4.w; ((float4*)(dst + (size_t)row * 1024))[lane + 64 * i] = o4; }
        } else {
            if (lane == 0) rstd[row] = r;
#pragma unroll
            for (int i = 0; i < 4; ++i) { u32x2 w; w[0] = pk2(v[i].x, v[i].y); w[1] = pk2(v[i].z, v[i].w); *(u32x2*)(xb + (size_t)row * 1024 + 4 * (lane + 64 * i)) = w; }
        }
    }
}

DI void lru_item(const Params& p, int l, int item, unsigned char* lds, int pass) {
    const int tid = otid(), lane = tid & 63, w = tid >> 6, q = lane >> 4, fr = lane & 15;
    const int h = item & 7, n = (item >> 3) & 63, b = item >> 9;
    const size_t t0 = (size_t)b * 4096 + (size_t)n * 64;
    float* xcf = (float*)lds;
    bf16_t* xcb = (bf16_t*)(lds + 33792);
    float* ssq_s = (float*)(lds + 51200);
    float* tot_s = (float*)(lds + 53248);
    const bf16_t* lrux = (const bf16_t*)(p.ws + OFF_LRUX);
    bf16_t* zy = (bf16_t*)(p.ws + OFF_ZY);
    float2* agg = (float2*)(p.ws + OFF_AGG);
    {
        const int t = tid >> 3, cg8 = tid & 7, ch = h * 128 + cg8 * 16;
        float a[16];
#pragma unroll
        for (int e = 0; e < 16; ++e) a[e] = p.lru_conv_b[l * 1024 + ch + e];
#pragma unroll
        for (int j = 0; j < 4; ++j) {
            const int tt = n * 64 + t - 3 + j;
            if (tt >= 0) {
                const bf16_t* sp = lrux + ((size_t)b * 4096 + tt) * 1024 + ch;
                float xv[16]; unpack8(*(const u32x4*)sp, xv); unpack8(*(const u32x4*)(sp + 8), xv + 8);
                const float* wp = p.lru_conv_w + (size_t)(l * 4 + j) * 1024 + ch;
#pragma unroll
                for (int e = 0; e < 16; ++e) a[e] += wp[e] * xv[e];
            }
        }
#pragma unroll
        for (int e = 0; e < 16; e += 4) *(float4*)(xcf + t * 132 + cg8 * 16 + e) = make_float4(a[e], a[e + 1], a[e + 2], a[e + 3]);
        u32x4 w0, w1;
#pragma unroll
        for (int e = 0; e < 4; ++e) { w0[e] = pk2(a[2 * e], a[2 * e + 1]); w1[e] = pk2(a[8 + 2 * e], a[8 + 2 * e + 1]); }
        *(u32x4*)(xcb + t * 136 + cg8 * 16) = w0; *(u32x4*)(xcb + t * 136 + cg8 * 16 + 8) = w1;
    }
    __syncthreads();
    f32x4 ga[4], gx[4];
#pragma unroll
    for (int m = 0; m < 4; ++m) { ga[m] = (f32x4){0.f, 0.f, 0.f, 0.f}; gx[m] = (f32x4){0.f, 0.f, 0.f, 0.f}; }
    const bf16_t* wg = (const bf16_t*)(p.ws + OFF_WG) + (size_t)(l * 8 + h) * 256 * 128;
#pragma unroll
    for (int ks = 0; ks < 4; ++ks) {
        const bf16x8 fa = *(const bf16x8*)(wg + (size_t)(16 * w + fr) * 128 + 32 * ks + 8 * q);
        const bf16x8 fx = *(const bf16x8*)(wg + (size_t)(128 + 16 * w + fr) * 128 + 32 * ks + 8 * q);
#pragma unroll
        for (int m = 0; m < 4; ++m) {
            const bf16x8 a_ = *(const bf16x8*)(xcb + (16 * m + fr) * 136 + 32 * ks + 8 * q);
            ga[m] = MFMA16(a_, fa, ga[m]); gx[m] = MFMA16(a_, fx, gx[m]);
        }
    }
    const int j = 16 * w + fr, chj = h * 128 + j;
    const float ba_j = p.lru_ba[l * 1024 + chj], bx_j = p.lru_bx[l * 1024 + chj];
    const float sp8 = -8.f * softplusf_(-p.lru_lambda[l * 1024 + chj]);
    float av[4][4], bv[4][4], A_[4], H_[4];
#pragma unroll
    for (int m = 0; m < 4; ++m) {
        float Aa = 1.f, Hh = 0.f;
#pragma unroll
        for (int i = 0; i < 4; ++i) {
            const int t = 16 * m + 4 * q + i;
            const float r = sigmoidf_(ga[m][i] + ba_j), ig = sigmoidf_(gx[m][i] + bx_j);
            const float la = sp8 * r, a = __expf(la), mult = sqrtf(fmaxf(-expm1f(2.f * la), 0.f));
            const float bb = mult * ig * xcf[t * 132 + j];
            av[m][i] = a; bv[m][i] = bb; Hh = a * Hh + bb; Aa *= a;
        }
        A_[m] = Aa; H_[m] = Hh;
    }
    if (pass == 1) {
        float At = 1.f, Ht = 0.f;
#pragma unroll
        for (int m = 0; m < 4; ++m)
#pragma unroll
            for (int qq = 0; qq < 4; ++qq) { const float a2 = __shfl(A_[m], fr + 16 * qq), h2 = __shfl(H_[m], fr + 16 * qq); Ht = a2 * Ht + h2; At *= a2; }
        if (q == 0) agg[((size_t)b * 64 + n) * 1024 + chj] = make_float2(At, Ht);
        __syncthreads();
        return;
    }
    float carry = 0.f;
    for (int nn = 0; nn < n; ++nn) { const float2 ag = agg[((size_t)b * 64 + nn) * 1024 + chj]; carry = ag.x * carry + ag.y; }
    float hv[4][4];
#pragma unroll
    for (int m = 0; m < 4; ++m) {
        float hs = carry;
#pragma unroll
        for (int qq = 0; qq < 4; ++qq) {
            const float a2 = __shfl(A_[m], fr + 16 * qq), h2 = __shfl(H_[m], fr + 16 * qq);
            if (qq < q) hs = a2 * hs + h2;
            carry = a2 * carry + h2;
        }
#pragma unroll
        for (int i = 0; i < 4; ++i) { hs = av[m][i] * hs + bv[m][i]; hv[m][i] = hs; }
    }
#pragma unroll
    for (int m = 0; m < 4; ++m)
#pragma unroll
        for (int i = 0; i < 4; ++i) {
            float s = hv[m][i] * hv[m][i];
            s += __shfl_xor(s, 1); s += __shfl_xor(s, 2); s += __shfl_xor(s, 4); s += __shfl_xor(s, 8);
            if (fr == 0) ssq_s[w * 64 + 16 * m + 4 * q + i] = s;
        }
    __syncthreads();
    if (tid < 64) { float t_ = 0.f;
#pragma unroll
        for (int ww = 0; ww < 8; ++ww) t_ += ssq_s[ww * 64 + tid];
        tot_s[tid] = rsqrtf(t_ * (1.f / 128.f) + 1e-6f); }
    __syncthreads();
    const float nwj = p.lru_norm_w[l * 1024 + chj];
#pragma unroll
    for (int m = 0; m < 4; ++m)
#pragma unroll
        for (int i = 0; i < 4; ++i) {
            const int t = 16 * m + 4 * q + i;
            const size_t ad = (t0 + t) * 2048 + chj;
            const float z = bf2f(zy[ad]);
            zy[ad] = f2bf(hv[m][i] * tot_s[t] * nwj * z * sigmoidf_(z));
        }
    __syncthreads();
}

DI void dn_local_item(const Params& p, int l, int item, unsigned char* lds) {
    const int tid = otid(), lane = tid & 63, w = tid >> 6, q = lane >> 4, fr = lane & 15;
    const int n = item & 63, h = (item >> 6) & 7, b = item >> 9;
    bf16_t* qt = (bf16_t*)lds;
    bf16_t* kt = (bf16_t*)(lds + 17408);
    float* As = (float*)(lds + 34816);
    float* Xs = (float*)(lds + 51456);
    float* tmp = (float*)(lds + 68096);
    float* g_s = (float*)(lds + 71232);
    float* gc_s = g_s + 64; float* beta_s = g_s + 128;
    bf16_t* qkv = (bf16_t*)(p.ws + OFF_QKV);
    const bf16_t* halo = (const bf16_t*)(p.ws + OFF_HALO);
    bf16_t* ta = (bf16_t*)(p.ws + OFF_XB) + (size_t)item * 8192;
    const float* ba = (const float*)(p.ws + OFF_BA);
    const int t = tid >> 3, cg8 = tid & 7, d0 = cg8 * 16;
    const size_t tok = (size_t)b * 4096 + (size_t)n * 64 + t;
    const float beta = sigmoidf_(ba[tok * 16 + h]);
    const float g = -__expf(p.dn_A_log[l * 8 + h]) * softplusf_(ba[tok * 16 + 8 + h] + p.dn_dt_bias[l * 8 + h]);
    float val[3][16];
#pragma unroll
    for (int pl = 0; pl < 3; ++pl) {
        const bf16_t* blkp = qkv + (size_t)pl * PLANE_ + (size_t)item * 8192;
        const bf16_t* halop = halo + ((size_t)pl * 4096 + (item - 1)) * 384;
        float a[16];
#pragma unroll
        for (int e = 0; e < 16; ++e) a[e] = 0.f;
#pragma unroll
        for (int j = 0; j < 4; ++j) {
            const int rr = t - 3 + j;
            if (rr >= 0 || n > 0) {
                const bf16_t* sp = rr >= 0 ? blkp + rr * 128 + d0 : halop + (rr + 3) * 128 + d0;
                float xv[16]; unpack8(*(const u32x4*)sp, xv); unpack8(*(const u32x4*)(sp + 8), xv + 8);
                const float* wp = p.dn_conv_w + (size_t)(l * 4 + j) * 3072 + pl * 1024 + h * 128 + d0;
#pragma unroll
                for (int e = 0; e < 16; ++e) a[e] += wp[e] * xv[e];
            }
        }
        float ss = 0.f;
#pragma unroll
        for (int e = 0; e < 16; ++e) { a[e] = a[e] * sigmoidf_(a[e]); ss += a[e] * a[e]; }
        if (pl < 2) {
            ss += __shfl_xor(ss, 1); ss += __shfl_xor(ss, 2); ss += __shfl_xor(ss, 4);
            const float sc = rsqrtf(ss + 1e-6f) * (pl == 0 ? 0.08838834764831845f : 1.f);
#pragma unroll
            for (int e = 0; e < 16; ++e) a[e] *= sc;
        } else {
#pragma unroll
            for (int e = 0; e < 16; ++e) a[e] *= beta;
        }
#pragma unroll
        for (int e = 0; e < 16; ++e) val[pl][e] = a[e];
    }
    u32x4 qw0, qw1, kw0, kw1;
#pragma unroll
    for (int e = 0; e < 4; ++e) { qw0[e] = pk2(val[0][2 * e], val[0][2 * e + 1]); qw1[e] = pk2(val[0][8 + 2 * e], val[0][9 + 2 * e]); kw0[e] = pk2(val[1][2 * e], val[1][2 * e + 1]); kw1[e] = pk2(val[1][8 + 2 * e], val[1][9 + 2 * e]); }
    *(u32x4*)(qt + t * 136 + d0) = qw0; *(u32x4*)(qt + t * 136 + d0 + 8) = qw1;
    *(u32x4*)(kt + t * 136 + d0) = kw0; *(u32x4*)(kt + t * 136 + d0 + 8) = kw1;
    if (cg8 == 0) { g_s[t] = g; beta_s[t] = beta; }
    for (int e = tid; e < 64 * 65; e += 512) Xs[e] = 0.f;
    __syncthreads();
    {
        bf16_t* qb = qkv + (size_t)item * 8192; bf16_t* kb = qkv + PLANE_ + (size_t)item * 8192; bf16_t* vb = qkv + 2 * PLANE_ + (size_t)item * 8192;
        *(u32x4*)(qb + t * 128 + d0) = qw0; *(u32x4*)(qb + t * 128 + d0 + 8) = qw1;
        *(u32x4*)(kb + t * 128 + d0) = kw0; *(u32x4*)(kb + t * 128 + d0 + 8) = kw1;
#pragma unroll
        for (int e = 0; e < 16; ++e) vb[(d0 + e) * 64 + t] = f2bf(val[2][e]);
    }
    if (w == 0) {
        float v = g_s[lane];
#pragma unroll
        for (int o = 1; o < 64; o <<= 1) { const float u = __shfl_up(v, o); if (lane >= o) v += u; }
        gc_s[lane] = v;
        const size_t gi = (size_t)(b * 8 + h) * 4096 + n * 64 + lane;
        ((float*)(p.ws + OFF_G))[gi] = g_s[lane]; ((float*)(p.ws + OFF_GC))[gi] = v; ((float*)(p.ws + OFF_BETA))[gi] = beta_s[lane];
    }
    __syncthreads();
    {
        const int mat = w >> 2, mt = w & 3;
        const bf16_t* at = mat ? qt : kt;
        f32x4 c4[4];
#pragma unroll
        for (int nt = 0; nt < 4; ++nt) c4[nt] = (f32x4){0.f, 0.f, 0.f, 0.f};
#pragma unroll
        for (int ks = 0; ks < 4; ++ks) {
            const bf16x8 a_ = *(const bf16x8*)(at + (16 * mt + fr) * 136 + 32 * ks + 8 * q);
#pragma unroll
            for (int nt = 0; nt < 4; ++nt) { const bf16x8 b_ = *(const bf16x8*)(kt + (16 * nt + fr) * 136 + 32 * ks + 8 * q); c4[nt] = MFMA16(a_, b_, c4[nt]); }
        }
#pragma unroll
        for (int nt = 0; nt < 4; ++nt)
#pragma unroll
            for (int i = 0; i < 4; ++i) {
                const int c = 16 * mt + 4 * q + i, jj = 16 * nt + fr;
                const float dec = __expf(fminf(gc_s[c] - gc_s[jj], 0.f));
                if (mat == 0) As[c * 65 + jj] = (jj < c) ? beta_s[c] * c4[nt][i] * dec : 0.f;
                else ta[4096 + c * 64 + jj] = f2bf((jj <= c) ? c4[nt][i] * dec : 0.f);
            }
    }
    __syncthreads();
    if (tid < 64) {
        const int b4 = tid >> 4, cc = tid & 15;
        float xx[16];
#pragma unroll
        for (int i = 0; i < 16; ++i) {
            float s = (i == cc) ? 1.f : 0.f;
#pragma unroll
            for (int jj = 0; jj < i; ++jj) s -= As[(b4 * 16 + i) * 65 + b4 * 16 + jj] * xx[jj];
            xx[i] = s;
        }
#pragma unroll
        for (int i = 0; i < 16; ++i) Xs[(b4 * 16 + i) * 65 + b4 * 16 + cc] = xx[i];
    }
    __syncthreads();
    for (int r = 1; r < 4; ++r) {
        const int wd = 16 * r;
        for (int e = tid; e < 16 * wd; e += 512) {
            const int i = e / wd, c = e % wd; float s = 0.f;
            for (int k = 0; k < wd; ++k) s += As[(wd + i) * 65 + k] * Xs[k * 65 + c];
            tmp[i * 49 + c] = s;
        }
        __syncthreads();
        for (int e = tid; e < 16 * wd; e += 512) {
            const int i = e / wd, c = e % wd; float s = 0.f;
#pragma unroll
            for (int k = 0; k < 16; ++k) s += Xs[(wd + i) * 65 + wd + k] * tmp[k * 49 + c];
            Xs[(wd + i) * 65 + c] = -s;
        }
        __syncthreads();
    }
    {
        const int row = tid >> 3, c8 = (tid & 7) * 8; u32x4 wv;
#pragma unroll
        for (int e = 0; e < 4; ++e) wv[e] = pk2(Xs[row * 65 + c8 + 2 * e], Xs[row * 65 + c8 + 2 * e + 1]);
        *(u32x4*)(ta + row * 64 + c8) = wv;
    }
    __syncthreads();
}

DI void dn_out_tile(const Params& p, int l, int bh, int n, const float* o_tile) {
    const int tid = otid(), t = tid >> 3, d0 = (tid & 7) * 16, b = bh >> 3, h = bh & 7;
    float o[16]; float ss = 0.f;
#pragma unroll
    for (int e = 0; e < 16; e += 4) { const float4 v = *(const float4*)(o_tile + t * 132 + d0 + e); o[e] = v.x; o[e + 1] = v.y; o[e + 2] = v.z; o[e + 3] = v.w; }
#pragma unroll
    for (int e = 0; e < 16; ++e) ss += o[e] * o[e];
    ss += __shfl_xor(ss, 1); ss += __shfl_xor(ss, 2); ss += __shfl_xor(ss, 4);
    const float r = rsqrtf(ss * (1.f / 128.f) + 1e-6f);
    bf16_t* zp = (bf16_t*)(p.ws + OFF_ZY) + ((size_t)b * 4096 + (size_t)n * 64 + t) * 2048 + 1024 + h * 128 + d0;
    float z[16]; unpack8(*(const u32x4*)zp, z); unpack8(*(const u32x4*)(zp + 8), z + 8);
    const float* nw = p.dn_norm_w + l * 128 + d0;
    float y[16];
#pragma unroll
    for (int e = 0; e < 16; ++e) y[e] = o[e] * r * nw[e] * z[e] * sigmoidf_(z[e]);
    u32x4 w0, w1;
#pragma unroll
    for (int e = 0; e < 4; ++e) { w0[e] = pk2(y[2 * e], y[2 * e + 1]); w1[e] = pk2(y[8 + 2 * e], y[9 + 2 * e]); }
    *(u32x4*)zp = w0; *(u32x4*)(zp + 8) = w1;
}

DI void dn_seq_naive(const Params& p, int l, int bh, unsigned char* lds) {
    const int tid = otid(), r = tid >> 7, e = tid & 127;
    float* k_s = (float*)lds; float* q_s = k_s + 128; float* red = q_s + 128; float* red2 = red + 512; float* o_tile = red2 + 512;
    const bf16_t* qkv = (const bf16_t*)(p.ws + OFF_QKV);
    const float* garr = (const float*)(p.ws + OFF_G) + (size_t)bh * 4096; const float* barr = (const float*)(p.ws + OFF_BETA) + (size_t)bh * 4096;
    float S[32];
#pragma unroll
    for (int i = 0; i < 32; ++i) S[i] = 0.f;
    for (int n = 0; n < 64; ++n) {
        const size_t blk = (size_t)(bh * 64 + n) * 8192;
        const bf16_t* qb = qkv + blk; const bf16_t* kb = qkv + PLANE_ + blk; const bf16_t* vb = qkv + 2 * PLANE_ + blk;
        for (int c = 0; c < 64; ++c) {
            if (tid < 128) k_s[tid] = bf2f(kb[c * 128 + tid]); else if (tid < 256) q_s[tid - 128] = bf2f(qb[c * 128 + tid - 128]);
            const float vbe = bf2f(vb[e * 64 + c]); const float eg = __expf(garr[n * 64 + c]), beta = barr[n * 64 + c];
            __syncthreads();
            float part = 0.f;
#pragma unroll
            for (int i = 0; i < 32; ++i) part += k_s[32 * r + i] * S[i];
            red[r * 128 + e] = part;
            __syncthreads();
            const float kS = red[e] + red[128 + e] + red[256 + e] + red[384 + e];
            const float vn = vbe - beta * eg * kS;
            float po = 0.f;
#pragma unroll
            for (int i = 0; i < 32; ++i) { S[i] = eg * S[i] + k_s[32 * r + i] * vn; po += q_s[32 * r + i] * S[i]; }
            red2[r * 128 + e] = po;
            __syncthreads();
            if (r == 0) o_tile[c * 132 + e] = red2[e] + red2[128 + e] + red2[256 + e] + red2[384 + e];
        }
        __syncthreads();
        dn_out_tile(p, l, bh, n, o_tile);
        __syncthreads();
    }
}

DI void run_phase(const Params& p, int ph, unsigned char* shm) {
    unsigned char* ws = p.ws;
#ifndef PHM
#define PHM 63
#endif
    if (ph == 0) { if (PHM & 1) prep_phase(p, shm); rownorm_phase(p.x, (bf16_t*)(ws + OFF_XB), (float*)(ws + OFF_RSTD), nullptr, nullptr); return; }
    const int l = (ph - 1) / 5, sub = (ph - 1) % 5;
    if (sub == 0) { if (PHM & 2) {
        pg8::Gemm g; g.A = (const bf16_t*)(ws + OFF_XB); g.Bt = (const bf16_t*)(ws + OFF_WIN) + (size_t)l * NPAD_ * 1024; g.M = M_; g.N = NPAD_; g.K = 1024;
        pg8::StaticOrder S; S.init(M_, NPAD_, (int)gridDim.x, (int)blockIdx.x);
        EpiIn E; E.rstd = (const float*)(ws + OFF_RSTD); E.ws = ws;
        pg8::gemm_phase<EpiIn, pg8::StaticOrder, false>((PG8_LAS unsigned char*)shm, g, S, E, nullptr); }
    } else if (sub == 1) { if (PHM & 4) {
        for (int it = blockIdx.x; it < 4096; it += gridDim.x) dn_local_item(p, l, it, shm);
        for (int it = blockIdx.x; it < 4096; it += gridDim.x) lru_item(p, l, it, shm, 1); }
    } else if (sub == 2) { if (PHM & 8) {
        if (blockIdx.x < 64) dn_seq_naive(p, l, blockIdx.x, shm);
        else for (int it = blockIdx.x - 64; it < 4096; it += gridDim.x - 64) lru_item(p, l, it, shm, 2); }
    } else if (sub == 3) { if (PHM & 16) {
        pg8::Gemm g; g.A = (const bf16_t*)(ws + OFF_ZY); g.Bt = (const bf16_t*)(ws + OFF_WOUT) + (size_t)l * 1024 * 2048; g.M = M_; g.N = 1024; g.K = 2048;
        pg8::StaticOrder S; S.init(M_, 1024, (int)gridDim.x, (int)blockIdx.x);
        EpiOut E; E.res = l == 0 ? p.x : p.out; E.out = p.out;
        pg8::gemm_phase<EpiOut, pg8::StaticOrder, false>((PG8_LAS unsigned char*)shm, g, S, E, nullptr); }
    } else {
        if (l == 0) rownorm_phase(p.out, (bf16_t*)(ws + OFF_XB), (float*)(ws + OFF_RSTD), nullptr, nullptr);
        else rownorm_phase(p.out, nullptr, nullptr, p.final_norm_w, p.out);
    }
}

__global__ void __launch_bounds__(512, 2) hymba_mega(Params p) {
    extern __shared__ __attribute__((aligned(16))) unsigned char shm[];
    cg::grid_group grid = cg::this_grid();
    for (int ph = p.ph_lo; ph < p.ph_hi; ++ph) {
        if (ph > p.ph_lo) grid.sync();
        run_phase(p, ph, shm);
    }
}

extern "C" void kernel_launch(void* const* d_in, const int* in_sizes, int n_in, void* d_out, int out_size, void* d_ws, size_t ws_size, hipStream_t stream) {
    static int grid = 0;
    if (grid == 0) {
        if (n_in != 17 || in_sizes[0] != M_ * 1024 || out_size != M_ * 1024 || ws_size < WS_END) {
            fprintf(stderr, "kernel_launch: unexpected shapes (n_in %d, in0 %d, out %d, ws %zu, need %zu); nothing launched\n", n_in, n_in > 0 ? in_sizes[0] : -1, out_size, ws_size, (size_t)WS_END);
            grid = -1; return;
        }
        if (hipFuncSetAttribute((const void*)hymba_mega, hipFuncAttributeMaxDynamicSharedMemorySize, LDS_BYTES) != hipSuccess) { fprintf(stderr, "kernel_launch: hipFuncSetAttribute failed\n"); grid = -1; return; }
        int dev = 0, cus = 0, per_cu = 0;
        hipGetDevice(&dev); hipDeviceGetAttribute(&cus, hipDeviceAttributeMultiprocessorCount, dev);
        if (hipOccupancyMaxActiveBlocksPerMultiprocessor(&per_cu, (const void*)hymba_mega, 512, LDS_BYTES) != hipSuccess || per_cu < 1) { fprintf(stderr, "kernel_launch: occupancy query says %d blocks per CU\n", per_cu); per_cu = 1; }
        (void)hipGetLastError();
        grid = cus;
        fprintf(stderr, "kernel_launch: grid %d (cus %d, per_cu %d)\n", grid, cus, per_cu);
    }
    if (grid < 0) return;
    Params p{};
    const float** pp = (const float**)&p;
    for (int i = 0; i < 17; ++i) pp[i] = (const float*)d_in[i];
    p.out = (float*)d_out; p.ws = (unsigned char*)d_ws;
#if MK_SINGLE
    p.ph_lo = 0; p.ph_hi = N_PHASES;
    void* args[] = {&p};
    hipError_t e = hipLaunchCooperativeKernel((const void*)hymba_mega, dim3(grid), dim3(512), args, LDS_BYTES, stream);
    if (e != hipSuccess) fprintf(stderr, "kernel_launch: cooperative launch failed: %s (grid %d)\n", hipGetErrorString(e), grid);
#else
    for (int ph = 0; ph < N_PHASES; ++ph) {
        p.ph_lo = ph; p.ph_hi = ph + 1;
        hipLaunchKernelGGL(hymba_mega, dim3(grid), dim3(512), LDS_BYTES, stream, p);
    }
#endif
}
```

```cpp
#include <hip/hip_runtime.h>
#include <hip/hip_cooperative_groups.h>
#include <cstdio>
namespace cg = cooperative_groups;
#ifndef MK_SINGLE
#define MK_SINGLE 1
#endif
namespace pg8 {
#define PG8_LAS __attribute__((address_space(3)))
typedef unsigned short bf16_t;
typedef short bf16x8 __attribute__((ext_vector_type(8)));
typedef float f32x4 __attribute__((ext_vector_type(4)));
typedef unsigned u32x4 __attribute__((ext_vector_type(4)));
constexpr int BM = 256, BK = 64, HALF = 128, HTB = HALF * BK * 2  , STAGE_BYTES = 8 * HTB, NXCD = 8, WGM = 4;

__host__ __device__ __forceinline__ int lds_byte(int r, int c) { const int st = (r >> 4) * 2 + (c >> 5), rr = r & 15, cc = c & 31, ob = rr * 64 + cc * 2; return st * 1024 + (ob ^ (((ob >> 9) & 1) << 5)); }
__host__ __device__ __forceinline__ void stage_rc(int b, int& R, int& C) { const int st = b / 1024, sb = b % 1024, swz = sb ^ (((sb >> 9) & 1) << 5); R = (st >> 1) * 16 + swz / 64; C = (st & 1) * 32 + (swz % 64) / 2; }
__host__ __device__ __forceinline__ int perm32(int rho) { const int n = rho >> 4, i = rho & 15; return 8 * (i >> 2) + 4 * n + (i & 3); }

struct Unit { int pm, pn; };
struct Gemm { const bf16_t* A; const bf16_t* Bt; int M, N, K; };

struct StaticOrder {
    int nM, nN, nwg, G, c;
    __host__ __device__ void init(int M, int N, int G_, int c_) { nM = M / BM; nN = N / BM; nwg = nM * nN; G = G_; c = c_; }
    __host__ __device__ bool next(int i, Unit& u) const {
        const long L = (long)i * G + c; if (L >= nwg) return false;
        int wgid = (int)L; { const int q = nwg / NXCD, r = nwg % NXCD, xcd = wgid % NXCD, off = wgid / NXCD; wgid = (xcd < r ? xcd * (q + 1) : r * (q + 1) + (xcd - r) * q) + off; }
        const int nig = WGM * nN, gid = wgid / nig, fm = gid * WGM, gsz = (nM - fm) < WGM ? (nM - fm) : WGM;
        u.pm = fm + ((wgid % nig) % gsz); u.pn = (wgid % nig) / gsz; return true;
    }
    __device__ __forceinline__ void a_ready(const Unit&) const {}
    __device__ __forceinline__ void done(const Unit&) const {}
};
__device__ __forceinline__ unsigned cvt_pk_bf16(float lo, float hi) { unsigned r; asm volatile("v_cvt_pk_bf16_f32 %0, %1, %2" : "=v"(r) : "v"(lo), "v"(hi)); return r; }
template <class Epi, class Sched, bool STAMP = false>
__device__ __forceinline__ void gemm_phase(PG8_LAS unsigned char* lds, const Gemm g, const Sched& S, const Epi& E, unsigned long long* stamps) {
    int tid_ = threadIdx.x; asm volatile("" : "+v"(tid_)); const int tid = tid_, wid = __builtin_amdgcn_readfirstlane(tid >> 6), lane = tid & 63, wr = wid >> 2, wc = wid & 3, fr = lane & 15, fq = lane >> 4;
    const int K = g.K, nt = K / BK;
    int ts_lo = 0, ts_hi = 0, nts = 0; const unsigned long long rt_entry = STAMP ? (unsigned long long)wall_clock64() : 0ull;
#define PG8_STAMP() do { if (STAMP && wid == 0 && nts < 64) { const unsigned long long _c = (unsigned long long)clock64(); \
        ts_lo = (lane == nts) ? (int)(unsigned)_c : ts_lo; ts_hi = (lane == nts) ? (int)(unsigned)(_c >> 32) : ts_hi; ++nts; } } while (0)
    PG8_STAMP();
    unsigned voffA[2], voffB[2];
#pragma unroll
    for (int i = 0; i < 2; ++i) { int R, C; stage_rc(tid * 16 + i * 8192, R, C); const int Rb = Epi::PERM ? ((R & ~31) + perm32(R & 31)) : R;
        voffA[i] = (unsigned)(R * K + C) * 2u; voffB[i] = (unsigned)(Rb * K + C) * 2u; }
    const size_t kstep = (size_t)(BK * 2);
    const size_t hstep = (size_t)HALF * K * 2;
    const size_t tstep = 2 * hstep;
    const unsigned ldsw = (unsigned)wid * 1024u;
    const int aoff = lds_byte(wr * 64 + fr, fq * 8), boff = lds_byte(wc * 32 + fr, fq * 8);
#define PG8_SA(b, h) (((b) * 2 + (h)) * HTB)
#define PG8_SB(b, h) ((4 + (b) * 2 + (h)) * HTB)
#define PG8_STAGE(bufoff, gbase, voff) do { _Pragma("unroll") for (int _i = 0; _i < 2; ++_i) \
        __builtin_amdgcn_global_load_lds((const unsigned*)((const char*)(gbase) + (voff)[_i]), (PG8_LAS unsigned*)(lds + (bufoff) + ldsw + _i * 8192), 16, 0, 0); } while (0)
#define PG8_LDA(dst, b, h) do { _Pragma("unroll") for (int m = 0; m < 4; ++m) _Pragma("unroll") for (int k = 0; k < 2; ++k) dst[m][k] = *(const PG8_LAS bf16x8*)(lds + PG8_SA(b, h) + aoff + m * 2048 + k * 1024); } while (0)
#define PG8_LDB(dst, b, h) do { _Pragma("unroll") for (int n = 0; n < 2; ++n) _Pragma("unroll") for (int k = 0; k < 2; ++k) dst[n][k] = *(const PG8_LAS bf16x8*)(lds + PG8_SB(b, h) + boff + n * 2048 + k * 1024); } while (0)
#define PG8_MMA(ai, bj, At, Bt) do { __builtin_amdgcn_s_setprio(1); _Pragma("unroll") for (int m = 0; m < 4; ++m) _Pragma("unroll") for (int n = 0; n < 2; ++n) _Pragma("unroll") for (int k = 0; k < 2; ++k) \
        acc[ai][bj][m][n] = __builtin_amdgcn_mfma_f32_16x16x32_bf16(Bt[n][k], At[m][k], acc[ai][bj][m][n], 0, 0, 0); __builtin_amdgcn_s_setprio(0); } while (0)
#define PG8_WAIT_V(n) asm volatile("s_waitcnt vmcnt(" #n ")" ::: "memory")
#define PG8_WAIT_L(n) asm volatile("s_waitcnt lgkmcnt(" #n ")" ::: "memory")
#define PG8_BAR __builtin_amdgcn_s_barrier()
#define PG8_SCHED __builtin_amdgcn_sched_barrier(0)
    Unit cur, nxt; int ui = 0;
    if (!S.next(0, cur)) return;
    f32x4 acc[2][2][4][2];
#pragma unroll
    for (int a = 0; a < 2; ++a)
#pragma unroll
        for (int b = 0; b < 2; ++b)
#pragma unroll
            for (int m = 0; m < 4; ++m)
#pragma unroll
                for (int n = 0; n < 2; ++n) acc[a][b][m][n] = (f32x4){0.f, 0.f, 0.f, 0.f};
    bf16x8 At[4][2], B0[2][2], B1[2][2];
    const char* cA = (const char*)g.A + (size_t)cur.pm * tstep; const char* cB = (const char*)g.Bt + (size_t)cur.pn * tstep;
    S.a_ready(cur);
    PG8_STAGE(PG8_SB(0, 0), cB, voffB); PG8_STAGE(PG8_SA(0, 0), cA, voffA); PG8_STAGE(PG8_SB(0, 1), cB + hstep, voffB); PG8_STAGE(PG8_SA(0, 1), cA + hstep, voffA);
    if (wr == 1) PG8_BAR;
    PG8_WAIT_V(4); PG8_BAR;
    PG8_STAGE(PG8_SB(1, 0), cB + kstep, voffB); PG8_STAGE(PG8_SA(1, 0), cA + kstep, voffA); PG8_STAGE(PG8_SB(1, 1), cB + hstep + kstep, voffB);
    PG8_WAIT_V(6); PG8_BAR;
    PG8_STAMP();
    for (;;) {
        const bool has_next = S.next(ui + 1, nxt);
        const char* nA = has_next ? (const char*)g.A + (size_t)nxt.pm * tstep : cA; const char* nB = has_next ? (const char*)g.Bt + (size_t)nxt.pn * tstep : cB;
        for (int t = 0; t < nt; t += 2) {
            const bool last = (t == nt - 2);
            const char* a1 = cA + (size_t)(t + 1) * kstep;
            const char* a2 = last ? nA : cA + (size_t)(t + 2) * kstep; const char* b2 = last ? nB : cB + (size_t)(t + 2) * kstep;
            const char* a3 = a2 + kstep; const char* b3 = b2 + kstep;
            if (last && has_next) S.a_ready(nxt);
            PG8_LDB(B0, 0, 0); PG8_SCHED; PG8_LDA(At, 0, 0); PG8_STAGE(PG8_SA(1, 1), a1 + hstep, voffA);
            PG8_WAIT_L(8); PG8_BAR; PG8_WAIT_L(0); PG8_MMA(0, 0, At, B0); PG8_BAR; PG8_SCHED;
            PG8_LDB(B1, 0, 1); PG8_STAGE(PG8_SB(0, 0), b2, voffB);
            PG8_BAR; PG8_WAIT_L(0); PG8_MMA(0, 1, At, B1); PG8_BAR;
            PG8_LDA(At, 0, 1); PG8_STAGE(PG8_SA(0, 0), a2, voffA);
            PG8_BAR; PG8_WAIT_L(0); PG8_MMA(1, 0, At, B0); PG8_BAR; PG8_SCHED;
            PG8_STAGE(PG8_SB(0, 1), b2 + hstep, voffB);
            PG8_WAIT_V(6); PG8_BAR; PG8_MMA(1, 1, At, B1); PG8_BAR;
            PG8_LDB(B0, 1, 0); PG8_SCHED; PG8_LDA(At, 1, 0); PG8_STAGE(PG8_SA(0, 1), a2 + hstep, voffA);
            PG8_WAIT_L(8); PG8_BAR; PG8_WAIT_L(0); PG8_MMA(0, 0, At, B0); PG8_BAR; PG8_SCHED;
            PG8_LDB(B1, 1, 1); PG8_STAGE(PG8_SB(1, 0), b3, voffB);
            PG8_BAR; PG8_WAIT_L(0); PG8_MMA(0, 1, At, B1); PG8_BAR;
            PG8_LDA(At, 1, 1); PG8_STAGE(PG8_SA(1, 0), a3, voffA);
            PG8_BAR; PG8_WAIT_L(0); PG8_MMA(1, 0, At, B0); PG8_BAR; PG8_SCHED;
            PG8_STAGE(PG8_SB(1, 1), b3 + hstep, voffB);
            PG8_WAIT_V(6); PG8_BAR; PG8_MMA(1, 1, At, B1); PG8_BAR;
        }
        PG8_STAMP();
        if constexpr (!Epi::AFTER_DRAIN) { E(acc, cur, wr, wc, fr, fq); S.done(cur); }
        PG8_STAMP();
        if (!has_next) break;
#pragma unroll
        for (int a = 0; a < 2; ++a)
#pragma unroll
            for (int b = 0; b < 2; ++b)
#pragma unroll
                for (int m = 0; m < 4; ++m)
#pragma unroll
                    for (int n = 0; n < 2; ++n) acc[a][b][m][n] = (f32x4){0.f, 0.f, 0.f, 0.f};
        cur = nxt; cA = nA; cB = nB; ++ui;
    }
    PG8_WAIT_V(0);
    if (wr == 0) PG8_BAR;
    PG8_BAR;
    if constexpr (Epi::AFTER_DRAIN) { E.fused(acc, cur, wr, wc, fr, fq, lds, wid, lane); S.done(cur); }
    PG8_STAMP();
    if (STAMP && wid == 0) { stamps[lane] = lane < nts ? (((unsigned long long)(unsigned)ts_hi << 32) | (unsigned)ts_lo) : 0ull;
        if (lane == 62) stamps[62] = rt_entry; if (lane == 63) stamps[63] = (unsigned long long)wall_clock64(); }
#undef PG8_STAMP
#undef PG8_SA
#undef PG8_SB
#undef PG8_STAGE
#undef PG8_LDA
#undef PG8_LDB
#undef PG8_MMA
#undef PG8_WAIT_V
#undef PG8_WAIT_L
#undef PG8_BAR
#undef PG8_SCHED
}
}

using pg8::bf16_t; using pg8::bf16x8; using pg8::f32x4; using pg8::u32x4;
typedef unsigned u32x2 __attribute__((ext_vector_type(2)));
#define DI __device__ __forceinline__
#define MFMA16(a, b, c) __builtin_amdgcn_mfma_f32_16x16x32_bf16((a), (b), (c), 0, 0, 0)

constexpr int D_ = 1024, SEQ_ = 4096, M_ = 32768, DIN_ = 6160, NPAD_ = 6400;
constexpr size_t PLANE_ = (size_t)M_ * 1024;
constexpr size_t OFF_WIN = 0;
constexpr size_t OFF_WOUT = OFF_WIN + (size_t)2 * NPAD_ * 1024 * 2;
constexpr size_t OFF_WG = OFF_WOUT + (size_t)2 * 1024 * 2048 * 2;
constexpr size_t OFF_XB = OFF_WG + (size_t)2 * 8 * 256 * 128 * 2;
constexpr size_t OFF_LRUX = OFF_XB + PLANE_ * 2;
constexpr size_t OFF_ZY = OFF_LRUX + PLANE_ * 2;
constexpr size_t OFF_QKV = OFF_ZY + PLANE_ * 4;
constexpr size_t OFF_HALO = OFF_QKV + PLANE_ * 6;
constexpr size_t OFF_BA = OFF_HALO + (size_t)3 * 4096 * 3 * 128 * 2;
constexpr size_t OFF_RSTD = OFF_BA + (size_t)M_ * 16 * 4;
constexpr size_t OFF_G = OFF_RSTD + (size_t)M_ * 4;
constexpr size_t OFF_GC = OFF_G + (size_t)M_ * 8 * 4;
constexpr size_t OFF_BETA = OFF_GC + (size_t)M_ * 8 * 4;
constexpr size_t OFF_AGG = OFF_BETA + (size_t)M_ * 8 * 4;
constexpr size_t OFF_BG = OFF_AGG + (size_t)8 * 64 * 1024 * 2 * 4;
constexpr size_t OFF_DL = OFF_BG + (size_t)M_ * 8 * 4;
constexpr size_t OFF_CTR = OFF_DL + (size_t)M_ * 8 * 4;
constexpr size_t WS_END = OFF_CTR + 8192;
constexpr int LDS_BYTES = 131072 + 16;
constexpr int N_PHASES = 11;

struct Params {
    const float *x, *norm_w, *w_in, *lru_conv_w, *lru_conv_b, *lru_wa, *lru_ba, *lru_wx, *lru_bx, *lru_lambda, *lru_norm_w,
        *dn_conv_w, *dn_A_log, *dn_dt_bias, *dn_norm_w, *w_out, *final_norm_w;
    float* out;
    unsigned char* ws;
    int ph_lo, ph_hi;
};

DI int otid() { int t = threadIdx.x; asm volatile("" : "+v"(t)); return t; }
typedef const __attribute__((address_space(4))) Params* CP;
DI bf16_t f2bf(float f) { unsigned u = __float_as_uint(f); u += 0x7FFFu + ((u >> 16) & 1u); return (bf16_t)(u >> 16); }
DI float bf2f(bf16_t b) { return __uint_as_float(((unsigned)b) << 16); }
typedef float f32x2_ __attribute__((ext_vector_type(2)));
typedef __bf16 bf16x2_ __attribute__((ext_vector_type(2)));
DI unsigned pkcvt(float lo, float hi) { f32x2_ v = {lo, hi}; bf16x2_ b = __builtin_convertvector(v, bf16x2_); return __builtin_bit_cast(unsigned, b); }
DI unsigned pk2(float lo, float hi) { return pkcvt(lo, hi); }
DI float sigmoidf_(float x) { return __builtin_amdgcn_rcpf(1.f + __expf(-x)); }
DI float softplusf_(float x) { return x > 20.f ? x : log1pf(__expf(x)); }
DI float softplus_fast(float x) { return x > 20.f ? x : __logf(1.f + __expf(x)); }
DI void unpack8(const u32x4 v, float* o) {
#pragma unroll
    for (int i = 0; i < 4; ++i) { o[2 * i] = __uint_as_float(v[i] << 16); o[2 * i + 1] = __uint_as_float(v[i] & 0xFFFF0000u); }
}

struct EpiIn {
    static constexpr bool PERM = true, AFTER_DRAIN = false;
    const float* rstd; unsigned char* ws;
    DI void operator()(const f32x4 (&acc)[2][2][4][2], const pg8::Unit& u, int wr, int wc, int fr, int fq) const {
        const int row0 = u.pm * 256 + wr * 64 + fr;
        const int pn = u.pn;
        if (pn == 24) {
            if (wc == 0 && fq < 2) {
                float* ba = (float*)(ws + OFF_BA) + (size_t)row0 * 16 + 8 * fq;
#pragma unroll
                for (int ai = 0; ai < 2; ++ai)
#pragma unroll
                    for (int m = 0; m < 4; ++m) {
                        const float s = 1.f;
#pragma unroll
                        for (int n = 0; n < 2; ++n) { f32x4 v = acc[ai][0][m][n] * s; *(f32x4*)(ba + (size_t)(ai * 128 + m * 16) * 16 + 4 * n) = v; }
                    }
            }
            return;
        }
        const int region = pn >> 2;
        const int colr = (pn & 3) * 256 + wc * 32 + 8 * fq;
        bf16_t* base; int SA, SB, SM; bf16_t* hbase = nullptr;
        if (region == 0) { base = (bf16_t*)(ws + OFF_LRUX) + (size_t)row0 * 1024 + colr; SA = 128 * 1024; SB = 128; SM = 16 * 1024; }
        else if (region == 1 || region == 5) { base = (bf16_t*)(ws + OFF_ZY) + (size_t)row0 * 2048 + colr + (region == 5 ? 1024 : 0); SA = 128 * 2048; SB = 128; SM = 16 * 2048; }
        else {
            const int pl = region - 2, h0 = (pn & 3) * 2, d = wc * 32 + 8 * fq, b = u.pm >> 4, n0 = (u.pm * 4 + wr) & 63;
            const int blk = (b * 8 + h0) * 64 + n0;
            base = (bf16_t*)(ws + OFF_QKV) + (size_t)pl * PLANE_ + ((size_t)blk * 64 + fr) * 128 + d; SA = 2 * 8192; SB = 64 * 8192; SM = 16 * 128;
            hbase = (bf16_t*)(ws + OFF_HALO) + (((size_t)pl * 4096 + blk) * 3 + (fr - 13)) * 128 + d;
        }
#pragma unroll
        for (int ai = 0; ai < 2; ++ai)
#pragma unroll
            for (int m = 0; m < 4; ++m) {
                const float s = 1.f;
#pragma unroll
                for (int bj = 0; bj < 2; ++bj) {
                    f32x4 v0 = acc[ai][bj][m][0] * s, v1 = acc[ai][bj][m][1] * s;
                    if (region == 1 || region == 5) {
#pragma unroll
                        for (int k = 0; k < 4; ++k) { v0[k] = v0[k] * sigmoidf_(v0[k]); v1[k] = v1[k] * sigmoidf_(v1[k]); }
                    }
                    u32x4 w; w[0] = pg8::cvt_pk_bf16(v0[0], v0[1]); w[1] = pg8::cvt_pk_bf16(v0[2], v0[3]); w[2] = pg8::cvt_pk_bf16(v1[0], v1[1]); w[3] = pg8::cvt_pk_bf16(v1[2], v1[3]);
                    *(u32x4*)(base + (size_t)ai * SA + (size_t)bj * SB + (size_t)m * SM) = w;
                    if (m == 3 && hbase != nullptr && fr >= 13) *(u32x4*)(hbase + ai * (2 * 384) + bj * (64 * 384)) = w;
                }
                asm volatile("" ::: "memory");
            }
    }
};
struct EpiOut {
    static constexpr bool PERM = false, AFTER_DRAIN = false;
    const float* res; float* out;
    DI void operator()(const f32x4 (&acc)[2][2][4][2], const pg8::Unit& u, int wr, int wc, int fr, int fq) const {
        const int row0 = u.pm * 256 + wr * 64 + fr, col0 = u.pn * 256 + wc * 32 + 4 * fq;
#pragma unroll
        for (int ai = 0; ai < 2; ++ai)
#pragma unroll
            for (int m = 0; m < 4; ++m) {
                const size_t ro = (size_t)(row0 + ai * 128 + m * 16) * 1024 + col0;
#pragma unroll
                for (int bj = 0; bj < 2; ++bj)
#pragma unroll
                    for (int n = 0; n < 2; ++n) { const f32x4 rv = *(const f32x4*)(res + ro + bj * 128 + n * 16); *(f32x4*)(out + ro + bj * 128 + n * 16) = rv + acc[ai][bj][m][n]; }
            }
    }
};

struct TileDesc { const float* src; const float* scale; bf16_t* dst; int src_ld, C, dst_ld, r0, c0; };
DI TileDesc prep_tile(CP p, int idx) {
    bf16_t* WinT = (bf16_t*)(p->ws + OFF_WIN); bf16_t* WoutT = (bf16_t*)(p->ws + OFF_WOUT); bf16_t* WgT = (bf16_t*)(p->ws + OFF_WG);
    TileDesc d;
    if (idx < 3200) {
        const int l = idx / 1600, t = idx % 1600, rt = t / 100, ct = t % 100;
        d.src = p->w_in + (size_t)l * 1024 * DIN_; d.src_ld = DIN_; d.C = DIN_; d.scale = p->norm_w + l * 1024; d.dst = WinT + (size_t)l * NPAD_ * 1024; d.dst_ld = 1024; d.r0 = rt * 64; d.c0 = ct * 64;
    } else if (idx < 4224) {
        const int j = idx - 3200, l = j / 512, t = j % 512, rt = t / 16, ct = t % 16;
        d.src = p->w_out + (size_t)l * 2048 * 1024; d.src_ld = 1024; d.C = 1024; d.scale = nullptr; d.dst = WoutT + (size_t)l * 1024 * 2048; d.dst_ld = 2048; d.r0 = rt * 64; d.c0 = ct * 64;
    } else {
        const int j = idx - 4224, l = j / 64, g = (j / 32) & 1, h = (j / 4) & 7, tt = j & 3, rt = tt >> 1, ct = tt & 1;
        d.src = (g ? p->lru_wx : p->lru_wa) + (size_t)(l * 8 + h) * 128 * 128; d.src_ld = 128; d.C = 128; d.scale = nullptr; d.dst = WgT + ((size_t)(l * 8 + h) * 256 + g * 128) * 128; d.dst_ld = 128; d.r0 = rt * 64; d.c0 = ct * 64;
    }
    return d;
}
DI void prep_load(const TileDesc& d, int tid, float4 (&v)[2]) {
#pragma unroll
    for (int i = 0; i < 2; ++i) {
        const int e = tid + 512 * i, rr = e >> 4, c4 = (e & 15) * 4; v[i] = make_float4(0.f, 0.f, 0.f, 0.f);
        if (d.c0 + c4 < d.C) { v[i] = *(const float4*)(d.src + (size_t)(d.r0 + rr) * d.src_ld + d.c0 + c4); if (d.scale) { const float sc = d.scale[d.r0 + rr]; v[i].x *= sc; v[i].y *= sc; v[i].z *= sc; v[i].w *= sc; } }
    }
}
DI void prep_phase(CP p, unsigned char* shm) {
    float* lds = (float*)shm;
    const int tid = otid();
    if ((int)blockIdx.x >= 4352) return;
    float4 v[2];
    TileDesc cur = prep_tile(p, blockIdx.x);
    prep_load(cur, tid, v);
    for (int idx = blockIdx.x; idx < 4352; idx += gridDim.x) {
#pragma unroll
        for (int i = 0; i < 2; ++i) { const int e = tid + 512 * i, rr = e >> 4, c4 = (e & 15) * 4; lds[rr * 65 + c4] = v[i].x; lds[rr * 65 + c4 + 1] = v[i].y; lds[rr * 65 + c4 + 2] = v[i].z; lds[rr * 65 + c4 + 3] = v[i].w; }
        __syncthreads();
        const TileDesc done = cur;
        if (idx + (int)gridDim.x < 4352) { cur = prep_tile(p, idx + gridDim.x); prep_load(cur, tid, v); }
        {
            const int cc = tid >> 3, r8 = (tid & 7) * 8; u32x4 wv;
#pragma unroll
            for (int e = 0; e < 4; ++e) wv[e] = pk2(lds[(r8 + 2 * e) * 65 + cc], lds[(r8 + 2 * e + 1) * 65 + cc]);
            *(u32x4*)(done.dst + (size_t)(done.c0 + cc) * done.dst_ld + done.r0 + r8) = wv;
        }
        __syncthreads();
    }
}
DI void rownorm_phase(const float* src, bf16_t* xb, float* rstd, const float* fw, float* dst) {
    const int tid = otid(); const int lane = tid & 63, wave = blockIdx.x * 8 + (tid >> 6), nw = gridDim.x * 8;
    for (int row = wave; row < M_; row += nw) {
        const float4* sp = (const float4*)(src + (size_t)row * 1024);
        float4 v[4]; float ss = 0.f;
#pragma unroll
        for (int i = 0; i < 4; ++i) { v[i] = sp[lane + 64 * i]; ss += v[i].x * v[i].x + v[i].y * v[i].y + v[i].z * v[i].z + v[i].w * v[i].w; }
#pragma unroll
        for (int o = 32; o >= 1; o >>= 1) ss += __shfl_xor(ss, o);
        const float r = __builtin_amdgcn_rsqf(ss * (1.f / 1024.f) + 1e-6f);
        if (fw) {
#pragma unroll
            for (int i = 0; i < 4; ++i) { const float4 w4 = ((const float4*)fw)[lane + 64 * i]; float4 o4; o4.x = v[i].x * r * w4.x; o4.y = v[i].y * r * w4.y; o4.z = v[i].z * r * w4.z; o4.w = v[i].w * r * w4.w; ((float4*)(dst + (size_t)row * 1024))[lane + 64 * i] = o4; }
        } else {
            if (lane == 0) rstd[row] = r;
#pragma unroll
            for (int i = 0; i < 4; ++i) { u32x2 w; w[0] = pk2(v[i].x * r, v[i].y * r); w[1] = pk2(v[i].z * r, v[i].w * r); *(u32x2*)(xb + (size_t)row * 1024 + 4 * (lane + 64 * i)) = w; }
        }
    }
}

DI void lru_phase(CP p, int l, int pass, int first, int stride, unsigned char* lds) {
    const int tid = otid(), lane = tid & 63, w = tid >> 6, q = lane >> 4, fr = lane & 15;
    const int h = first & 7;
    float* xcf = (float*)lds;
    bf16_t* xcb = (bf16_t*)(lds + 33792);
    float* ssq_s = (float*)(lds + 51200);
    float* tot_s = (float*)(lds + 53248);
    bf16_t* zt = (bf16_t*)(lds + 53504);
    float* cw = (float*)(lds + 70912);
    const bf16_t* lrux = (const bf16_t*)(p->ws + OFF_LRUX);
    bf16_t* zy = (bf16_t*)(p->ws + OFF_ZY);
    float2* agg = (float2*)(p->ws + OFF_AGG);
    if (first >= 4096) return;
    for (int e = tid; e < 640; e += 512) cw[e] = e < 512 ? p->lru_conv_w[(size_t)(l * 4 + (e >> 7)) * 1024 + h * 128 + (e & 127)] : p->lru_conv_b[l * 1024 + h * 128 + (e & 127)];
    const int j = 16 * w + fr, chj = h * 128 + j;
    const float ba_j = p->lru_ba[l * 1024 + chj], bx_j = p->lru_bx[l * 1024 + chj];
    const float sp8 = -8.f * softplusf_(-p->lru_lambda[l * 1024 + chj]);
    const float nwj = p->lru_norm_w[l * 1024 + chj];
    bf16x8 wfa[4], wfx[4];
    const bf16_t* wg = (const bf16_t*)(p->ws + OFF_WG) + (size_t)(l * 8 + h) * 256 * 128;
    if (pass == 1) {
#pragma unroll
        for (int ks = 0; ks < 4; ++ks) { wfa[ks] = *(const bf16x8*)(wg + (size_t)(16 * w + fr) * 128 + 32 * ks + 8 * q); wfx[ks] = *(const bf16x8*)(wg + (size_t)(128 + 16 * w + fr) * 128 + 32 * ks + 8 * q); }
    }
    const int t = tid >> 3, cg8 = tid & 7, ch = h * 128 + cg8 * 16;
    u32x4 xr[8], zr[2];
#define LRU_LOAD(item_) do { const int n_ = ((item_) >> 3) & 63, b_ = (item_) >> 9; \
        _Pragma("unroll") for (int j_ = 0; j_ < 4; ++j_) { const int tt_ = n_ * 64 + t - 3 + j_; \
            if (tt_ >= 0) { const bf16_t* sp_ = lrux + ((size_t)b_ * 4096 + tt_) * 1024 + ch; xr[2 * j_] = *(const u32x4*)sp_; xr[2 * j_ + 1] = *(const u32x4*)(sp_ + 8); } \
            else { xr[2 * j_] = (u32x4){0, 0, 0, 0}; xr[2 * j_ + 1] = (u32x4){0, 0, 0, 0}; } } \
        if (pass == 2) { _Pragma("unroll") for (int i_ = 0; i_ < 2; ++i_) { const int e_ = tid + 512 * i_; \
            zr[i_] = *(const u32x4*)(zy + ((size_t)b_ * 4096 + n_ * 64 + (e_ >> 4)) * 2048 + h * 128 + (e_ & 15) * 8); } } } while (0)
#define LRU_AGG_LOAD(item_) do { const int n_ = ((item_) >> 3) & 63, b_ = (item_) >> 9; \
        _Pragma("unroll") for (int k_ = 0; k_ < 16; ++k_) { const int nn_ = 16 * q + k_; ag[k_] = (nn_ < n_) ? agg[((size_t)b_ * 64 + nn_) * 1024 + chj] : make_float2(1.f, 0.f); } } while (0)
#define LRU_AGG_FOLD() do { float Ap_ = 1.f, Hp_ = 0.f; \
        _Pragma("unroll") for (int k_ = 0; k_ < 16; ++k_) { Hp_ = ag[k_].x * Hp_ + ag[k_].y; Ap_ *= ag[k_].x; } \
        carry_next = 0.f; \
        _Pragma("unroll") for (int qq_ = 0; qq_ < 4; ++qq_) { const float a2_ = __shfl(Ap_, fr + 16 * qq_), h2_ = __shfl(Hp_, fr + 16 * qq_); carry_next = a2_ * carry_next + h2_; } } while (0)
    float carry_next = 0.f;
    float2 ag[16];
    if (pass == 2) { LRU_AGG_LOAD(first); LRU_AGG_FOLD(); }
    LRU_LOAD(first);
    __syncthreads();
    for (int item = first; item < 4096; item += stride) {
        const int n = (item >> 3) & 63, b = item >> 9;
        const size_t t0 = (size_t)b * 4096 + (size_t)n * 64;
        {
            float a[16];
#pragma unroll
            for (int e = 0; e < 16; e += 4) { const float4 b4 = *(const float4*)(cw + 512 + cg8 * 16 + e); a[e] = b4.x; a[e + 1] = b4.y; a[e + 2] = b4.z; a[e + 3] = b4.w; }
#pragma unroll
            for (int jj = 0; jj < 4; ++jj) {
                float xv[16]; unpack8(xr[2 * jj], xv); unpack8(xr[2 * jj + 1], xv + 8);
#pragma unroll
                for (int e = 0; e < 16; e += 4) { const float4 w4 = *(const float4*)(cw + jj * 128 + cg8 * 16 + e); a[e] += w4.x * xv[e]; a[e + 1] += w4.y * xv[e + 1]; a[e + 2] += w4.z * xv[e + 2]; a[e + 3] += w4.w * xv[e + 3]; }
            }
#pragma unroll
            for (int e = 0; e < 16; e += 4) *(float4*)(xcf + t * 132 + cg8 * 16 + e) = make_float4(a[e], a[e + 1], a[e + 2], a[e + 3]);
            u32x4 w0, w1;
#pragma unroll
            for (int e = 0; e < 4; ++e) { w0[e] = pk2(a[2 * e], a[2 * e + 1]); w1[e] = pk2(a[8 + 2 * e], a[8 + 2 * e + 1]); }
            *(u32x4*)(xcb + t * 136 + cg8 * 16) = w0; *(u32x4*)(xcb + t * 136 + cg8 * 16 + 8) = w1;
            if (pass == 2) {
#pragma unroll
                for (int i = 0; i < 2; ++i) { const int e = tid + 512 * i; *(u32x4*)(zt + (e >> 4) * 136 + (e & 15) * 8) = zr[i]; }
            }
        }
        if (pass == 1 && item + stride < 4096) LRU_LOAD(item + stride);
        __syncthreads();
        f32x4 ga[4], gx[4];
#pragma unroll
        for (int m = 0; m < 4; ++m) { ga[m] = (f32x4){0.f, 0.f, 0.f, 0.f}; gx[m] = (f32x4){0.f, 0.f, 0.f, 0.f}; }
#pragma unroll
        for (int ks = 0; ks < 4; ++ks) {
            if (pass == 2) { wfa[ks] = *(const bf16x8*)(wg + (size_t)(16 * w + fr) * 128 + 32 * ks + 8 * q); wfx[ks] = *(const bf16x8*)(wg + (size_t)(128 + 16 * w + fr) * 128 + 32 * ks + 8 * q); }
#pragma unroll
            for (int m = 0; m < 4; ++m) {
                const bf16x8 a_ = *(const bf16x8*)(xcb + (16 * m + fr) * 136 + 32 * ks + 8 * q);
                ga[m] = MFMA16(a_, wfa[ks], ga[m]); gx[m] = MFMA16(a_, wfx[ks], gx[m]);
            }
        }
        float av[4][4], bv[4][4], A_[4], H_[4];
#pragma unroll
        for (int m = 0; m < 4; ++m) {
            float Aa = 1.f, Hh = 0.f;
#pragma unroll
            for (int i = 0; i < 4; ++i) {
                const int tt = 16 * m + 4 * q + i;
                const float r = sigmoidf_(ga[m][i] + ba_j), ig = sigmoidf_(gx[m][i] + bx_j);
                const float la = sp8 * r, a = __expf(la), mult = __builtin_amdgcn_sqrtf(fmaxf(1.f - a * a, 0.f));
                const float bb = mult * ig * xcf[tt * 132 + j];
                av[m][i] = a; bv[m][i] = bb; Hh = a * Hh + bb; Aa *= a;
            }
            A_[m] = Aa; H_[m] = Hh;
        }
        if (pass == 1) {
            float At = 1.f, Ht = 0.f;
#pragma unroll
            for (int m = 0; m < 4; ++m)
#pragma unroll
                for (int qq = 0; qq < 4; ++qq) { const float a2 = __shfl(A_[m], fr + 16 * qq), h2 = __shfl(H_[m], fr + 16 * qq); Ht = a2 * Ht + h2; At *= a2; }
            if (q == 0) agg[((size_t)b * 64 + n) * 1024 + chj] = make_float2(At, Ht);
            __syncthreads();
            continue;
        }
        float carry = carry_next;
        float hv[4][4];
#pragma unroll
        for (int m = 0; m < 4; ++m) {
            float hs = carry;
#pragma unroll
            for (int qq = 0; qq < 4; ++qq) {
                const float a2 = __shfl(A_[m], fr + 16 * qq), h2 = __shfl(H_[m], fr + 16 * qq);
                if (qq < q) hs = a2 * hs + h2;
                carry = a2 * carry + h2;
            }
#pragma unroll
            for (int i = 0; i < 4; ++i) { hs = av[m][i] * hs + bv[m][i]; hv[m][i] = hs; }
        }
        if (item + stride < 4096) LRU_LOAD(item + stride);
#pragma unroll
        for (int m = 0; m < 4; ++m)
#pragma unroll
            for (int i = 0; i < 4; ++i) {
                float sq = hv[m][i] * hv[m][i];
                sq += __shfl_xor(sq, 1); sq += __shfl_xor(sq, 2); sq += __shfl_xor(sq, 4); sq += __shfl_xor(sq, 8);
                if (fr == 0) ssq_s[w * 64 + 16 * m + 4 * q + i] = sq;
            }
        __syncthreads();
        if (tid < 64) { float t_ = 0.f;
#pragma unroll
            for (int ww = 0; ww < 8; ++ww) t_ += ssq_s[ww * 64 + tid];
            tot_s[tid] = __builtin_amdgcn_rsqf(t_ * (1.f / 128.f) + 1e-6f); }
        __syncthreads();
#pragma unroll
        for (int m = 0; m < 4; ++m)
#pragma unroll
            for (int i = 0; i < 4; ++i) {
                const int tt = 16 * m + 4 * q + i;
                const float z = bf2f(zt[tt * 136 + j]);
                zt[tt * 136 + j] = (bf16_t)(pkcvt(hv[m][i] * tot_s[tt] * nwj * z, 0.f) & 0xFFFFu);
            }
        __syncthreads();
#pragma unroll
        for (int i = 0; i < 2; ++i) { const int e = tid + 512 * i; *(u32x4*)(zy + (t0 + (e >> 4)) * 2048 + h * 128 + (e & 15) * 8) = *(const u32x4*)(zt + (e >> 4) * 136 + (e & 15) * 8); }
        if (item + stride < 4096) { LRU_AGG_LOAD(item + stride); LRU_AGG_FOLD(); }
        __syncthreads();
    }
#undef LRU_AGG_LOAD
#undef LRU_AGG_FOLD
#undef LRU_LOAD
}

DI void dn_local_phase(CP p, int l, unsigned char* lds, unsigned long long& g_tsec) {
    const int tid0 = otid();
    const int h = blockIdx.x & 7, wg_h = blockIdx.x >> 3, n_wg_h = gridDim.x >> 3;
    bf16_t* qt = (bf16_t*)lds;
    bf16_t* kt = (bf16_t*)(lds + 17408);
    bf16_t* raw = (bf16_t*)(lds + 34816);
    float* As = (float*)(lds + 34816);
    float* Xs = (float*)(lds + 51456);
    float* Bs = (float*)(lds + 72000);
    float* g_s = (float*)(lds + 89600);
    float* gc_s = g_s + 64; float* beta_s = g_s + 128;
    float* cwl = (float*)(lds + 90368);
    bf16_t* vts = (bf16_t*)(lds + 96512);
    bf16_t* ats = (bf16_t*)(lds + 114944);
    bf16_t* qkv = (bf16_t*)(p->ws + OFF_QKV);
    const bf16_t* halo = (const bf16_t*)(p->ws + OFF_HALO);
    const float* ba = (const float*)(p->ws + OFF_BA);
    (void)gc_s;
    if (wg_h >= 512) return;
    for (int e = tid0; e < 1536; e += 512) { const int pl = e >> 9, j = (e >> 7) & 3, d = e & 127; cwl[e] = p->dn_conv_w[(size_t)(l * 4 + j) * 3072 + pl * 1024 + h * 128 + d]; }
    const float aexp = -__expf(p->dn_A_log[l * 8 + h]), dtb = p->dn_dt_bias[l * 8 + h];
    u32x4 rr_[7];
#define DNL_LOAD(item_) do { const int n_ = (item_) & 63; \
        _Pragma("unroll") for (int i_ = 0; i_ < 7; ++i_) { const int e_ = tid + 512 * i_; const int pl_ = e_ / 1072, rem_ = e_ - pl_ * 1072, r_ = rem_ >> 4, c8_ = (rem_ & 15) * 8; \
            rr_[i_] = (u32x4){0u, 0u, 0u, 0u}; \
            if (e_ < 3216) { if (r_ >= 3) rr_[i_] = *(const u32x4*)(qkv + (size_t)pl_ * PLANE_ + (size_t)(item_) * 8192 + (r_ - 3) * 128 + c8_); \
                             else if (n_ > 0) rr_[i_] = *(const u32x4*)(halo + (((size_t)pl_ * 4096 + ((item_) - 1)) * 3 + r_) * 128 + c8_); } } } while (0)
    {
        const int tid = tid0;
        const int b0 = wg_h >> 6, n0 = wg_h & 63;
        DNL_LOAD((b0 * 8 + h) * 64 + n0);
    }
    for (int rest = wg_h; rest < 512; rest += n_wg_h) {
    int tid_ = tid0; asm volatile("" : "+v"(tid_));
    const int tid = tid_, lane = tid & 63, w = tid >> 6, q = lane >> 4, fr = lane & 15;
    const int b = rest >> 6, n = rest & 63, item = (b * 8 + h) * 64 + n;
#ifdef TS_SEC
    unsigned long long tq0_ = wall_clock64();
#endif
    bf16_t* ta = (bf16_t*)(p->ws + OFF_XB) + (size_t)item * 8192;
#pragma unroll
    for (int i = 0; i < 7; ++i) { const int e = tid + 512 * i; const int pl = e / 1072, rem = e - pl * 1072; if (e < 3216) *(u32x4*)(raw + (pl * 67 + (rem >> 4)) * 136 + (rem & 15) * 8) = rr_[i]; }
    __syncthreads();
    if (rest + n_wg_h < 512) { const int r2 = rest + n_wg_h; DNL_LOAD((((r2 >> 6) * 8 + h) * 64 + (r2 & 63))); }
    const int t = tid >> 3, cg8 = tid & 7, d0 = cg8 * 16;
    const size_t tok = (size_t)b * 4096 + (size_t)n * 64 + t;
    const float beta = sigmoidf_(ba[tok * 16 + h]);
    const float g = aexp * softplus_fast(ba[tok * 16 + 8 + h] + dtb);
    float val[3][16];
#pragma unroll
    for (int pl = 0; pl < 3; ++pl) {
        float a[16];
#pragma unroll
        for (int e = 0; e < 16; ++e) a[e] = 0.f;
#pragma unroll
        for (int j = 0; j < 4; ++j) {
            const bf16_t* sp = raw + (pl * 67 + t + j) * 136 + d0;
            float xv[16]; unpack8(*(const u32x4*)sp, xv); unpack8(*(const u32x4*)(sp + 8), xv + 8);
            const float* wp = cwl + (pl * 4 + j) * 128 + d0;
#pragma unroll
            for (int e = 0; e < 16; e += 4) { const float4 w4 = *(const float4*)(wp + e); a[e] += w4.x * xv[e]; a[e + 1] += w4.y * xv[e + 1]; a[e + 2] += w4.z * xv[e + 2]; a[e + 3] += w4.w * xv[e + 3]; }
        }
        float ss = 0.f;
#pragma unroll
        for (int e = 0; e < 16; ++e) { a[e] = a[e] * sigmoidf_(a[e]); ss += a[e] * a[e]; }
        if (pl < 2) {
            ss += __shfl_xor(ss, 1); ss += __shfl_xor(ss, 2); ss += __shfl_xor(ss, 4);
            const float sc = __builtin_amdgcn_rsqf(ss + 1e-6f) * (pl == 0 ? 0.08838834764831845f : 1.f);
#pragma unroll
            for (int e = 0; e < 16; ++e) a[e] *= sc;
        } else {
#pragma unroll
            for (int e = 0; e < 16; ++e) a[e] *= beta;
        }
#pragma unroll
        for (int e = 0; e < 16; ++e) val[pl][e] = a[e];
    }
    u32x4 qw0, qw1, kw0, kw1;
#pragma unroll
    for (int e = 0; e < 4; ++e) { qw0[e] = pk2(val[0][2 * e], val[0][2 * e + 1]); qw1[e] = pk2(val[0][8 + 2 * e], val[0][9 + 2 * e]); kw0[e] = pk2(val[1][2 * e], val[1][2 * e + 1]); kw1[e] = pk2(val[1][8 + 2 * e], val[1][9 + 2 * e]); }
    *(u32x4*)(qt + t * 136 + d0) = qw0; *(u32x4*)(qt + t * 136 + d0 + 8) = qw1;
    *(u32x4*)(kt + t * 136 + d0) = kw0; *(u32x4*)(kt + t * 136 + d0 + 8) = kw1;
    if (cg8 == 0) { g_s[t] = g; beta_s[t] = beta; }
    __syncthreads();
    for (int e = tid; e < 64 * 65; e += 512) Xs[e] = 0.f;
#ifdef TS_SEC
    { const unsigned long long tq_ = wall_clock64(); if (TS_SEC == 2 && l == 0) g_tsec += tq_ - tq0_; tq0_ = tq_; }
#endif
    {
        bf16_t* qb = qkv + (size_t)item * 8192; bf16_t* kb = qkv + PLANE_ + (size_t)item * 8192; bf16_t* vb = qkv + 2 * PLANE_ + (size_t)item * 8192;
        *(u32x4*)(qb + t * 128 + d0) = qw0; *(u32x4*)(qb + t * 128 + d0 + 8) = qw1;
        *(u32x4*)(kb + t * 128 + d0) = kw0; *(u32x4*)(kb + t * 128 + d0 + 8) = kw1;
        (void)vb;
#pragma unroll
        for (int e = 0; e < 16; e += 2) { const unsigned pk_ = pk2(val[2][e], val[2][e + 1]); vts[(d0 + e) * 72 + t] = (bf16_t)(pk_ & 0xFFFFu); vts[(d0 + e + 1) * 72 + t] = (bf16_t)(pk_ >> 16); }
    }
    float gcl;
    {
        float v = g_s[lane];
#pragma unroll
        for (int o = 1; o < 64; o <<= 1) { const float u = __shfl_up(v, o); if (lane >= o) v += u; }
        gcl = v;
        if (w == 0) {
            const size_t gi = (size_t)(b * 8 + h) * 4096 + n * 64 + lane;
            const float eg_ = __expf(v), gl_ = __shfl(v, 63);
            ((float*)(p->ws + OFF_G))[gi] = g_s[lane]; ((float*)(p->ws + OFF_GC))[gi] = eg_; ((float*)(p->ws + OFF_BETA))[gi] = beta_s[lane];
            ((float*)(p->ws + OFF_BG))[gi] = beta_s[lane] * eg_; ((float*)(p->ws + OFF_DL))[gi] = __expf(gl_ - v);
        }
    }
    {
        const int mat = w >> 2, mt = w & 3;
        const bf16_t* at = mat ? qt : kt;
        f32x4 c4[4];
#pragma unroll
        for (int nt = 0; nt < 4; ++nt) c4[nt] = (f32x4){0.f, 0.f, 0.f, 0.f};
#pragma unroll
        for (int ks = 0; ks < 4; ++ks) {
            const bf16x8 a_ = *(const bf16x8*)(at + (16 * mt + fr) * 136 + 32 * ks + 8 * q);
#pragma unroll
            for (int nt = 0; nt < 4; ++nt) { const bf16x8 b_ = *(const bf16x8*)(kt + (16 * nt + fr) * 136 + 32 * ks + 8 * q); c4[nt] = MFMA16(a_, b_, c4[nt]); }
        }
        float gcc[4], gcj[4];
#pragma unroll
        for (int i = 0; i < 4; ++i) { gcc[i] = __shfl(gcl, 16 * mt + 4 * q + i); gcj[i] = __shfl(gcl, 16 * i + fr); }
#pragma unroll
        for (int nt = 0; nt < 4; ++nt)
#pragma unroll
            for (int i = 0; i < 4; ++i) {
                const int c = 16 * mt + 4 * q + i, jj = 16 * nt + fr;
                const float dec = __expf(fminf(gcc[i] - gcj[nt], 0.f));
                if (mat == 0) As[c * 65 + jj] = (jj < c) ? beta_s[c] * c4[nt][i] * dec : 0.f;
                else ats[c * 72 + jj] = (bf16_t)(pk2((jj <= c) ? c4[nt][i] * dec : 0.f, 0.f) & 0xFFFFu);
            }
    }
    __syncthreads();
    {
        bf16_t* vbg = qkv + 2 * PLANE_ + (size_t)item * 8192;
#pragma unroll
        for (int i = 0; i < 2; ++i) { const int e = tid + 512 * i; *(u32x4*)(vbg + (e >> 3) * 64 + (e & 7) * 8) = *(const u32x4*)(vts + (e >> 3) * 72 + (e & 7) * 8); }
        *(u32x4*)(ta + 4096 + (tid >> 3) * 64 + (tid & 7) * 8) = *(const u32x4*)(ats + (tid >> 3) * 72 + (tid & 7) * 8);
    }
#ifdef TS_SEC
    { const unsigned long long tq_ = wall_clock64(); if (TS_SEC == 3 && l == 0) g_tsec += tq_ - tq0_; tq0_ = tq_; }
#endif
    if (tid < 64) {
        const int b4 = tid >> 4, cc = tid & 15;
        float xx[16];
#pragma unroll
        for (int i = 0; i < 16; ++i) {
            float s = (i == cc) ? 1.f : 0.f;
#pragma unroll
            for (int jj = 0; jj < i; ++jj) s -= As[(b4 * 16 + i) * 65 + b4 * 16 + jj] * xx[jj];
            xx[i] = s;
        }
#pragma unroll
        for (int i = 0; i < 16; ++i) Xs[(b4 * 16 + i) * 65 + b4 * 16 + cc] = xx[i];
    }
    __syncthreads();
#define MFMA_F32(a, b, c) __builtin_amdgcn_mfma_f32_16x16x4f32((a), (b), (c), 0, 0, 0)
    if (w < 6) {
        const int r = w == 0 ? 1 : (w < 3 ? 2 : 3), cb = w == 0 ? 0 : (w < 3 ? w - 1 : w - 3), wd = 16 * r;
        f32x4 acc0 = (f32x4){0.f, 0.f, 0.f, 0.f}, acc1 = (f32x4){0.f, 0.f, 0.f, 0.f};
#pragma unroll
        for (int sk = 0; sk < 4; sk += 2) {
            acc0 = MFMA_F32(Xs[(wd + fr) * 65 + wd + 4 * sk + q], As[(wd + 4 * sk + q) * 65 + 16 * cb + fr], acc0);
            acc1 = MFMA_F32(Xs[(wd + fr) * 65 + wd + 4 * (sk + 1) + q], As[(wd + 4 * (sk + 1) + q) * 65 + 16 * cb + fr], acc1);
        }
#pragma unroll
        for (int i = 0; i < 4; ++i) Bs[((r - 1) * 16 + 4 * q + i) * 49 + 16 * cb + fr] = -(acc0[i] + acc1[i]);
    }
    __syncthreads();
#pragma unroll
    for (int r = 1; r < 4; ++r) {
        const int wd = 16 * r;
        if (w < r) {
            const int cb = w;
            f32x4 acc0 = (f32x4){0.f, 0.f, 0.f, 0.f}, acc1 = (f32x4){0.f, 0.f, 0.f, 0.f};
#pragma unroll
            for (int sk = 0; sk < 4 * r; sk += 2) {
                if (sk >= 4 * cb) {
                    acc0 = MFMA_F32(Bs[((r - 1) * 16 + fr) * 49 + 4 * sk + q], Xs[(4 * sk + q) * 65 + 16 * cb + fr], acc0);
                    acc1 = MFMA_F32(Bs[((r - 1) * 16 + fr) * 49 + 4 * (sk + 1) + q], Xs[(4 * (sk + 1) + q) * 65 + 16 * cb + fr], acc1);
                }
            }
#pragma unroll
            for (int i = 0; i < 4; ++i) Xs[(wd + 4 * q + i) * 65 + 16 * cb + fr] = acc0[i] + acc1[i];
        }
        __syncthreads();
    }
#undef MFMA_F32
#ifdef TS_SEC
    { const unsigned long long tq_ = wall_clock64(); if (TS_SEC == 4 && l == 0) g_tsec += tq_ - tq0_; tq0_ = tq_; }
#endif
    {
        const int row = tid >> 3, c8 = (tid & 7) * 8; u32x4 wv;
#pragma unroll
        for (int e = 0; e < 4; ++e) wv[e] = pk2(Xs[row * 65 + c8 + 2 * e], Xs[row * 65 + c8 + 2 * e + 1]);
        *(u32x4*)(ta + row * 64 + c8) = wv;
    }
    __syncthreads();
    }
#undef DNL_LOAD
}

DI void dn_out_tile(CP p, int l, int bh, int n, const float* o_tile, const bool have_z = false, const u32x4 z0 = (u32x4){0, 0, 0, 0}, const u32x4 z1 = (u32x4){0, 0, 0, 0}) {
    const int tid = otid(), t = tid >> 3, d0 = (tid & 7) * 16, b = bh >> 3, h = bh & 7;
    float o[16]; float ss = 0.f;
#pragma unroll
    for (int e = 0; e < 16; e += 4) { const float4 v = *(const float4*)(o_tile + t * 132 + d0 + e); o[e] = v.x; o[e + 1] = v.y; o[e + 2] = v.z; o[e + 3] = v.w; }
#pragma unroll
    for (int e = 0; e < 16; ++e) ss += o[e] * o[e];
    ss += __shfl_xor(ss, 1); ss += __shfl_xor(ss, 2); ss += __shfl_xor(ss, 4);
    const float r = __builtin_amdgcn_rsqf(ss * (1.f / 128.f) + 1e-6f);
    bf16_t* zp = (bf16_t*)(p->ws + OFF_ZY) + ((size_t)b * 4096 + (size_t)n * 64 + t) * 2048 + 1024 + h * 128 + d0;
    float z[16];
    if (have_z) { unpack8(z0, z); unpack8(z1, z + 8); } else { unpack8(*(const u32x4*)zp, z); unpack8(*(const u32x4*)(zp + 8), z + 8); }
    const float* nw = p->dn_norm_w + l * 128 + d0;
    float y[16];
#pragma unroll
    for (int e = 0; e < 16; e += 4) { const float4 w4 = *(const float4*)(nw + e); y[e] = o[e] * r * w4.x * z[e]; y[e + 1] = o[e + 1] * r * w4.y * z[e + 1]; y[e + 2] = o[e + 2] * r * w4.z * z[e + 2]; y[e + 3] = o[e + 3] * r * w4.w * z[e + 3]; }
    u32x4 w0, w1;
#pragma unroll
    for (int e = 0; e < 4; ++e) { w0[e] = pk2(y[2 * e], y[2 * e + 1]); w1[e] = pk2(y[8 + 2 * e], y[9 + 2 * e]); }
    *(u32x4*)zp = w0; *(u32x4*)(zp + 8) = w1;
}

DI void dn_seq_naive(CP p, int l, int bh, unsigned char* lds) {
    const int tid = otid(), r = tid >> 7, e = tid & 127;
    float* k_s = (float*)lds; float* q_s = k_s + 128; float* red = q_s + 128; float* red2 = red + 512; float* o_tile = red2 + 512;
    const bf16_t* qkv = (const bf16_t*)(p->ws + OFF_QKV);
    const float* garr = (const float*)(p->ws + OFF_G) + (size_t)bh * 4096; const float* barr = (const float*)(p->ws + OFF_BETA) + (size_t)bh * 4096;
    float S[32];
#pragma unroll
    for (int i = 0; i < 32; ++i) S[i] = 0.f;
    for (int n = 0; n < 64; ++n) {
        const size_t blk = (size_t)(bh * 64 + n) * 8192;
        const bf16_t* qb = qkv + blk; const bf16_t* kb = qkv + PLANE_ + blk; const bf16_t* vb = qkv + 2 * PLANE_ + blk;
        for (int c = 0; c < 64; ++c) {
            if (tid < 128) k_s[tid] = bf2f(kb[c * 128 + tid]); else if (tid < 256) q_s[tid - 128] = bf2f(qb[c * 128 + tid - 128]);
            const float vbe = bf2f(vb[e * 64 + c]); const float eg = __expf(garr[n * 64 + c]), beta = barr[n * 64 + c];
            __syncthreads();
            float part = 0.f;
#pragma unroll
            for (int i = 0; i < 32; ++i) part += k_s[32 * r + i] * S[i];
            red[r * 128 + e] = part;
            __syncthreads();
            const float kS = red[e] + red[128 + e] + red[256 + e] + red[384 + e];
            const float vn = vbe - beta * eg * kS;
            float po = 0.f;
#pragma unroll
            for (int i = 0; i < 32; ++i) { S[i] = eg * S[i] + k_s[32 * r + i] * vn; po += q_s[32 * r + i] * S[i]; }
            red2[r * 128 + e] = po;
            __syncthreads();
            if (r == 0) o_tile[c * 132 + e] = red2[e] + red2[128 + e] + red2[256 + e] + red2[384 + e];
        }
        __syncthreads();
        dn_out_tile(p, l, bh, n, o_tile);
        __syncthreads();
    }
}


DI bf16x8 ldfrag(const bf16_t* p) {
    const u32x2 lo = *(const u32x2*)p, hi = *(const u32x2*)(p + 16);
    u32x4 v; v[0] = lo[0]; v[1] = lo[1]; v[2] = hi[0]; v[3] = hi[1];
    return __builtin_bit_cast(bf16x8, v);
}
DI bf16x8 packfrag(const f32x4 a, const f32x4 b) {
    u32x4 v; v[0] = pkcvt(a[0], a[1]); v[1] = pkcvt(a[2], a[3]); v[2] = pkcvt(b[0], b[1]); v[3] = pkcvt(b[2], b[3]);
    return __builtin_bit_cast(bf16x8, v);
}

DI void dn_seq_chunked(CP p, int l, int bh, unsigned char* lds, unsigned long long& g_tsec) {
    const int tid = otid(), lane = tid & 63, w = tid >> 6, q = lane >> 4, fr = lane & 15;
    bf16_t* qt = (bf16_t*)lds;
    bf16_t* kt = (bf16_t*)(lds + 17408);
    bf16_t* kT = (bf16_t*)(lds + 34816);
    bf16_t* vT = (bf16_t*)(lds + 53248);
    bf16_t* ti = (bf16_t*)(lds + 71680);
    bf16_t* at = (bf16_t*)(lds + 80896);
    float* eg_s = (float*)(lds + 90112);
    float* bg_s = eg_s + 64;
    float* dl_s = eg_s + 128;
    float* misc = eg_s + 192;
    float* o_tile = (float*)(lds + 91136);
    const bf16_t* qkv = (const bf16_t*)(p->ws + OFF_QKV);
    const bf16_t* tab0 = (const bf16_t*)(p->ws + OFF_XB);
    const float* pe = (const float*)(p->ws + OFF_GC) + (size_t)bh * 4096 + (tid & 63); const float* pb = (const float*)(p->ws + OFF_BG) + (size_t)bh * 4096 + (tid & 63); const float* pd = (const float*)(p->ws + OFF_DL) + (size_t)bh * 4096 + (tid & 63);
    const bf16_t* pq = qkv + (size_t)bh * 64 * 8192 + (tid >> 4) * 128 + (tid & 15) * 8;
    const bf16_t* pk = qkv + PLANE_ + (size_t)bh * 64 * 8192 + (tid & 63) * 128 + (tid >> 6) * 8;
    const bf16_t* pv = qkv + 2 * PLANE_ + (size_t)bh * 64 * 8192 + (tid >> 3) * 64 + (tid & 7) * 8;
    const bf16_t* pt = tab0 + (size_t)bh * 64 * 8192 + tid * 8;
    u32x4 rq[2], rk[2], rv[2], rt, ra, cz0, cz1; float reg = 0.f, rbg = 0.f, rdl = 0.f;
    const bf16_t* zbase = (const bf16_t*)(p->ws + OFF_ZY) + ((size_t)(bh >> 3) * 4096 + (tid >> 3)) * 2048 + 1024 + (bh & 7) * 128 + (tid & 7) * 16;
#define DN_PREFETCH(nn) do { \
        rq[0] = *(const u32x4*)pq; rq[1] = *(const u32x4*)(pq + 4096); rk[0] = *(const u32x4*)pk; rk[1] = *(const u32x4*)(pk + 64); \
        rv[0] = *(const u32x4*)pv; rv[1] = *(const u32x4*)(pv + 4096); rt = *(const u32x4*)pt; ra = *(const u32x4*)(pt + 4096); \
        if (tid < 64) { reg = *pe; rbg = *pb; rdl = *pd; } \
        pq += 8192; pk += 8192; pv += 8192; pt += 8192; pe += 64; pb += 64; pd += 64; } while (0)
#define DN_STORE() do { \
        _Pragma("unroll") for (int i_ = 0; i_ < 2; ++i_) { const int e_ = tid + 512 * i_; \
            *(u32x4*)(qt + (e_ >> 4) * 136 + (e_ & 15) * 8) = rq[i_]; \
            *(u32x4*)(kt + (e_ & 63) * 136 + (e_ >> 6) * 8) = rk[i_]; \
            _Pragma("unroll") for (int j_ = 0; j_ < 8; ++j_) kT[((e_ >> 6) * 8 + j_) * 72 + (e_ & 63)] = (bf16_t)(rk[i_][j_ >> 1] >> ((j_ & 1) * 16)); \
            *(u32x4*)(vT + (e_ >> 3) * 72 + (e_ & 7) * 8) = rv[i_]; } \
        *(u32x4*)(ti + (tid >> 3) * 72 + (tid & 7) * 8) = rt; *(u32x4*)(at + (tid >> 3) * 72 + (tid & 7) * 8) = ra; \
        if (tid < 64) { eg_s[tid] = reg; bg_s[tid] = rbg; dl_s[tid] = rdl; if (tid == 63) misc[0] = reg; } } while (0)
    f32x4 S[8];
#pragma unroll
    for (int m = 0; m < 8; ++m) S[m] = (f32x4){0.f, 0.f, 0.f, 0.f};
    DN_PREFETCH(0); DN_STORE();
    __syncthreads();
    for (int n = 0; n < 64; ++n) {
#ifdef TS_SEC
        unsigned long long tsa_ = wall_clock64();
#define TSQ(id) do { const unsigned long long t_ = wall_clock64(); if (TS_SEC == (id) && l == 0) g_tsec += t_ - tsa_; tsa_ = t_; } while (0)
#else
#define TSQ(id) do {} while (0)
#endif
#define SB() __builtin_amdgcn_sched_barrier(0)
        bf16x8 Sb[4];
#pragma unroll
        for (int s = 0; s < 4; ++s) Sb[s] = packfrag(S[2 * s], S[2 * s + 1]);
        bf16x8 fa[2][4];
#pragma unroll
        for (int s = 0; s < 4; ++s) fa[0][s] = ldfrag(kt + fr * 136 + 32 * s + 4 * q);
        f32x4 eg4[4];
#pragma unroll
        for (int mm = 0; mm < 4; ++mm) eg4[mm] = *(const f32x4*)(eg_s + 16 * mm + 4 * q);
        SB();
        const bool pf_ = n + 1 < 64;
        TSQ(11);
        f32x4 P[4], Q[4];
        bf16x8 ft[6], fk[2][8];
        u32x2 vv[4]; f32x4 bg[4];
#pragma unroll
        for (int u = 0; u < 8; ++u) {
            if (u < 7) {
                const bf16_t* src = ((u + 1) & 1) ? qt : kt;
#pragma unroll
                for (int s = 0; s < 4; ++s) fa[(u + 1) & 1][s] = ldfrag(src + (16 * ((u + 1) >> 1) + fr) * 136 + 32 * s + 4 * q);
            } else {
                ft[0] = ldfrag(ti + fr * 72 + 4 * q); ft[1] = ldfrag(ti + (16 + fr) * 72 + 4 * q);
                ft[2] = ldfrag(ti + (32 + fr) * 72 + 4 * q); ft[3] = ldfrag(ti + (32 + fr) * 72 + 32 + 4 * q);
                ft[4] = ldfrag(ti + (48 + fr) * 72 + 4 * q); ft[5] = ldfrag(ti + (48 + fr) * 72 + 32 + 4 * q);
            }
            if (u == 0) { cz0 = *(const u32x4*)(zbase + (size_t)n * 64 * 2048); if (pf_) rq[0] = *(const u32x4*)pq; }
            if (u == 1) { cz1 = *(const u32x4*)(zbase + (size_t)n * 64 * 2048 + 8); if (pf_) rq[1] = *(const u32x4*)(pq + 4096); }
            if (u == 2 && pf_) rk[0] = *(const u32x4*)pk;
            if (u == 3 && pf_) rk[1] = *(const u32x4*)(pk + 64);
            if (u == 4 && pf_) rv[0] = *(const u32x4*)pv;
            if (u == 5 && pf_) rv[1] = *(const u32x4*)(pv + 4096);
            if (u == 6 && pf_) rt = *(const u32x4*)pt;
            if (u == 7 && pf_) { ra = *(const u32x4*)(pt + 4096); if (tid < 64) { reg = *pe; rbg = *pb; rdl = *pd; } pq += 8192; pk += 8192; pv += 8192; pt += 8192; pe += 64; pb += 64; pd += 64; }
            SB();
            f32x4 acc_ = (f32x4){0.f, 0.f, 0.f, 0.f};
#pragma unroll
            for (int s = 0; s < 4; ++s) acc_ = MFMA16(fa[u & 1][s], Sb[s], acc_);
            if (u & 1) Q[u >> 1] = acc_ * eg4[u >> 1]; else P[u >> 1] = acc_;
            SB();
        }
        TSQ(12);
#pragma unroll
        for (int mm = 0; mm < 4; ++mm) { vv[mm] = *(const u32x2*)(vT + (16 * w + fr) * 72 + 16 * mm + 4 * q); bg[mm] = *(const f32x4*)(bg_s + 16 * mm + 4 * q); }
        f32x4 R[4];
#pragma unroll
        for (int m = 0; m < 4; ++m) {
            R[m][0] = __uint_as_float(vv[m][0] << 16) - bg[m][0] * P[m][0]; R[m][1] = __uint_as_float(vv[m][0] & 0xFFFF0000u) - bg[m][1] * P[m][1];
            R[m][2] = __uint_as_float(vv[m][1] << 16) - bg[m][2] * P[m][2]; R[m][3] = __uint_as_float(vv[m][1] & 0xFFFF0000u) - bg[m][3] * P[m][3];
        }
        bf16x8 Rb[2]; Rb[0] = packfrag(R[0], R[1]); Rb[1] = packfrag(R[2], R[3]);
        bf16x8 fo[6];
        fo[0] = ldfrag(at + fr * 72 + 4 * q); fo[1] = ldfrag(at + (16 + fr) * 72 + 4 * q);
        fo[2] = ldfrag(at + (32 + fr) * 72 + 4 * q); fo[3] = ldfrag(at + (32 + fr) * 72 + 32 + 4 * q);
        fo[4] = ldfrag(at + (48 + fr) * 72 + 4 * q); fo[5] = ldfrag(at + (48 + fr) * 72 + 32 + 4 * q);
        SB();
        f32x4 vn[4];
        vn[0] = MFMA16(ft[0], Rb[0], ((f32x4){0.f, 0.f, 0.f, 0.f}));
        vn[1] = MFMA16(ft[1], Rb[0], ((f32x4){0.f, 0.f, 0.f, 0.f}));
        vn[2] = MFMA16(ft[2], Rb[0], ((f32x4){0.f, 0.f, 0.f, 0.f})); vn[2] = MFMA16(ft[3], Rb[1], vn[2]);
        vn[3] = MFMA16(ft[4], Rb[0], ((f32x4){0.f, 0.f, 0.f, 0.f})); vn[3] = MFMA16(ft[5], Rb[1], vn[3]);
        SB();
        bf16x8 Vb[2]; Vb[0] = packfrag(vn[0], vn[1]); Vb[1] = packfrag(vn[2], vn[3]);
#pragma unroll
        for (int mm = 0; mm < 4; ++mm) { fk[0][2 * mm] = ldfrag(kT + (16 * mm + fr) * 72 + 4 * q); fk[0][2 * mm + 1] = ldfrag(kT + (16 * mm + fr) * 72 + 32 + 4 * q); }
        SB();
        {
            f32x4 o0 = Q[0], o1 = Q[1], o2 = Q[2], o3 = Q[3];
            o0 = MFMA16(fo[0], Vb[0], o0); o1 = MFMA16(fo[1], Vb[0], o1);
            o2 = MFMA16(fo[2], Vb[0], o2); o3 = MFMA16(fo[4], Vb[0], o3);
            o2 = MFMA16(fo[3], Vb[1], o2); o3 = MFMA16(fo[5], Vb[1], o3);
            SB();
#pragma unroll
            for (int i = 0; i < 4; ++i) { o_tile[(4 * q + i) * 132 + 16 * w + fr] = o0[i]; o_tile[(16 + 4 * q + i) * 132 + 16 * w + fr] = o1[i]; o_tile[(32 + 4 * q + i) * 132 + 16 * w + fr] = o2[i]; o_tile[(48 + 4 * q + i) * 132 + 16 * w + fr] = o3[i]; }
        }
        TSQ(13);
        const float egl = misc[0];
#pragma unroll
        for (int m = 0; m < 4; ++m) { const f32x4 dl = *(const f32x4*)(dl_s + 16 * m + 4 * q); vn[m] = vn[m] * dl; }
        bf16x8 Vd[2]; Vd[0] = packfrag(vn[0], vn[1]); Vd[1] = packfrag(vn[2], vn[3]);
#pragma unroll
        for (int mm = 0; mm < 4; ++mm) { fk[1][2 * mm] = ldfrag(kT + (64 + 16 * mm + fr) * 72 + 4 * q); fk[1][2 * mm + 1] = ldfrag(kT + (64 + 16 * mm + fr) * 72 + 32 + 4 * q); }
        SB();
#pragma unroll
        for (int mm = 0; mm < 4; ++mm) { f32x4 a_ = S[mm] * egl; a_ = MFMA16(fk[0][2 * mm], Vd[0], a_); a_ = MFMA16(fk[0][2 * mm + 1], Vd[1], a_); S[mm] = a_; }
        SB();
#pragma unroll
        for (int mm = 0; mm < 4; ++mm) { f32x4 a_ = S[4 + mm] * egl; a_ = MFMA16(fk[1][2 * mm], Vd[0], a_); a_ = MFMA16(fk[1][2 * mm + 1], Vd[1], a_); S[4 + mm] = a_; }
#undef SB
        TSQ(14);
        __syncthreads();
        TSQ(15);
        dn_out_tile(p, l, bh, n, o_tile, true, cz0, cz1);
        TSQ(16);
        if (n + 1 < 64) DN_STORE();
        TSQ(17);
        __syncthreads();
        TSQ(18);
    }
#undef DN_PREFETCH
#undef DN_STORE
#undef TSQ
}

DI void sub_barrier(unsigned* ctr, unsigned nblocks) {
    __syncthreads();
    if (threadIdx.x == 0) {
        __threadfence();
        __hip_atomic_fetch_add(ctr, 1u, __ATOMIC_RELAXED, __HIP_MEMORY_SCOPE_AGENT);
        { int bo_ = 1; while (__hip_atomic_load(ctr, __ATOMIC_RELAXED, __HIP_MEMORY_SCOPE_AGENT) < nblocks) { for (int k_ = 0; k_ < bo_; ++k_) __builtin_amdgcn_s_sleep(8); if (bo_ < 4) bo_ *= 2; } }
        __threadfence();
    }
    __syncthreads();
}

DI void run_phase(CP p, int ph, unsigned char* shm, unsigned long long& g_tsec) {
    unsigned char* ws = p->ws;
#ifndef PHM
#define PHM 63
#endif
    if (ph == 0) { if (blockIdx.x == 0) { ((unsigned*)(ws + OFF_CTR))[threadIdx.x] = 0u; ((unsigned*)(ws + OFF_CTR))[512 + threadIdx.x] = 0u; }
        if (PHM & 1) prep_phase(p, shm); rownorm_phase(p->x, (bf16_t*)(ws + OFF_XB), (float*)(ws + OFF_RSTD), nullptr, nullptr); return; }
    const int l = (ph - 1) / 5, sub = (ph - 1) % 5;
    if (sub == 0) { if (PHM & 2) {
        pg8::Gemm g; g.A = (const bf16_t*)(ws + OFF_XB); g.Bt = (const bf16_t*)(ws + OFF_WIN) + (size_t)l * NPAD_ * 1024; g.M = M_; g.N = NPAD_; g.K = 1024;
        pg8::StaticOrder S; S.init(M_, NPAD_, (int)gridDim.x, (int)blockIdx.x);
        EpiIn E; E.rstd = (const float*)(ws + OFF_RSTD); E.ws = ws;
        pg8::gemm_phase<EpiIn, pg8::StaticOrder, false>((PG8_LAS unsigned char*)shm, g, S, E, nullptr); }
    } else if (sub == 1) { if (PHM & 4) {
        dn_local_phase(p, l, shm, g_tsec);
        }
    } else if (sub == 2) { if (PHM & 8) {
        #ifdef DN_NAIVE
        if (blockIdx.x < 64) dn_seq_naive(p, l, blockIdx.x, shm);
#else
        if (blockIdx.x < 64) dn_seq_chunked(p, l, blockIdx.x, shm, g_tsec);
#endif
        else {
            lru_phase(p, l, 1, blockIdx.x - 64, gridDim.x - 64, shm);
            sub_barrier((unsigned*)(ws + OFF_CTR) + 16 * l, gridDim.x - 64);
            lru_phase(p, l, 2, blockIdx.x - 64, gridDim.x - 64, shm);
        } }
    } else if (sub == 3) { if (PHM & 16) {
        pg8::Gemm g; g.A = (const bf16_t*)(ws + OFF_ZY); g.Bt = (const bf16_t*)(ws + OFF_WOUT) + (size_t)l * 1024 * 2048; g.M = M_; g.N = 1024; g.K = 2048;
        pg8::StaticOrder S; S.init(M_, 1024, (int)gridDim.x, (int)blockIdx.x);
        EpiOut E; E.res = l == 0 ? p->x : p->out; E.out = p->out;
        pg8::gemm_phase<EpiOut, pg8::StaticOrder, false>((PG8_LAS unsigned char*)shm, g, S, E, nullptr); }
    } else {
        if (l == 0) rownorm_phase(p->out, (bf16_t*)(ws + OFF_XB), (float*)(ws + OFF_RSTD), nullptr, nullptr);
        else rownorm_phase(p->out, nullptr, nullptr, p->final_norm_w, p->out);
    }
}

__global__ void __launch_bounds__(512, 2) hymba_mega(Params p) {
    extern __shared__ __attribute__((aligned(16))) unsigned char shm[];
    cg::grid_group grid = cg::this_grid();
    unsigned long long g_tsec = 0;
#ifdef TS_PHASE
    unsigned long long ts0 = 0, ts1 = 0;
#endif
    unsigned* const bar_ = (unsigned*)(p.ws + OFF_CTR);
    volatile unsigned* const st_ = (volatile unsigned*)(shm + 131072);
    if (threadIdx.x == 0 && p.ph_lo == 0) bar_[1024 + blockIdx.x] = (unsigned)__builtin_amdgcn_s_getreg((3 << 11) | 20) & 0x7u;
    unsigned cseam = 0;
    for (int ph = p.ph_lo; ph < p.ph_hi; ++ph) {
        if (ph > p.ph_lo) {
            if (ph == p.ph_lo + 1 || p.ph_lo != 0) {
                grid.sync();
                if (threadIdx.x == 0 && p.ph_lo == 0) {
                    const unsigned x_ = (unsigned)__builtin_amdgcn_s_getreg((3 << 11) | 20) & 0x7u; unsigned mine_ = 0, mask_ = 0;
                    for (unsigned i_ = 0; i_ < gridDim.x; ++i_) { const unsigned v_ = bar_[1024 + i_]; mine_ += (v_ == x_) ? 1u : 0u; mask_ |= 1u << v_; }
                    st_[0] = mine_; st_[1] = (unsigned)__builtin_popcount(mask_);
                }
                __syncthreads();
            } else {
                ++cseam;
                asm volatile("s_waitcnt vmcnt(0)" ::: "memory");
                __syncthreads();
                if (threadIdx.x == 0) {
                    const unsigned x_ = (unsigned)__builtin_amdgcn_s_getreg((3 << 11) | 20) & 0x7u, nloc_ = st_[0], nx_ = st_[1];
                    unsigned* top_ = bar_ + 64;
                    if (__hip_atomic_fetch_add(bar_ + 128 + 64 * x_, 1u, __ATOMIC_RELAXED, __HIP_MEMORY_SCOPE_AGENT) + 1u == nloc_ * cseam) {
                        __builtin_amdgcn_fence(__ATOMIC_RELEASE, "agent");
                        asm volatile("s_waitcnt vmcnt(0)" ::: "memory");
                        __hip_atomic_fetch_add(top_, 1u, __ATOMIC_RELAXED, __HIP_MEMORY_SCOPE_AGENT);
                    }
                    { int bo_ = 1; unsigned spins_ = 0; const unsigned target_ = nx_ * cseam;
                      while (__hip_atomic_load(top_, __ATOMIC_RELAXED, __HIP_MEMORY_SCOPE_AGENT) < target_ && ++spins_ < (1u << 22)) { for (int k_ = 0; k_ < bo_; ++k_) __builtin_amdgcn_s_sleep(8); if (bo_ < 4) bo_ *= 2; } }
                    __builtin_amdgcn_fence(__ATOMIC_ACQUIRE, "agent");
                    asm volatile("s_waitcnt vmcnt(0)" ::: "memory");
                }
                __syncthreads();
            }
        }
#ifdef TS_PHASE
        if (ph == TS_PHASE) ts0 = wall_clock64();
#endif
        { CP pc = (CP)__builtin_amdgcn_kernarg_segment_ptr(); asm volatile("" : "+s"(pc)); run_phase(pc, ph, shm, g_tsec); }
#ifdef TS_PHASE
        if (ph == TS_PHASE) ts1 = wall_clock64();
#endif
    }
#ifdef TS_PHASE
    grid.sync();
    if (blockIdx.x == TS_BLOCK) {
#ifdef TS_SEC
        const long long K = (long long)g_tsec / 2;
#else
        const long long K = (long long)(ts1 - ts0) / 2;
#endif
        for (long long i = threadIdx.x; i < K && i < 500000; i += 512) p.out[(size_t)i * 64] += 0.08f; }
#endif
}

extern "C" void kernel_launch(void* const* d_in, const int* in_sizes, int n_in, void* d_out, int out_size, void* d_ws, size_t ws_size, hipStream_t stream) {
    static int grid = 0;
    if (grid == 0) {
        if (n_in != 17 || in_sizes[0] != M_ * 1024 || out_size != M_ * 1024 || ws_size < WS_END) {
            fprintf(stderr, "kernel_launch: unexpected shapes (n_in %d, in0 %d, out %d, ws %zu, need %zu); nothing launched\n", n_in, n_in > 0 ? in_sizes[0] : -1, out_size, ws_size, (size_t)WS_END);
            grid = -1; return;
        }
        if (hipFuncSetAttribute((const void*)hymba_mega, hipFuncAttributeMaxDynamicSharedMemorySize, LDS_BYTES) != hipSuccess) { fprintf(stderr, "kernel_launch: hipFuncSetAttribute failed\n"); grid = -1; return; }
        int dev = 0, cus = 0, per_cu = 0;
        hipGetDevice(&dev); hipDeviceGetAttribute(&cus, hipDeviceAttributeMultiprocessorCount, dev);
        if (hipOccupancyMaxActiveBlocksPerMultiprocessor(&per_cu, (const void*)hymba_mega, 512, LDS_BYTES) != hipSuccess || per_cu < 1) { fprintf(stderr, "kernel_launch: occupancy query says %d blocks per CU\n", per_cu); per_cu = 1; }
        (void)hipGetLastError();
        grid = cus;
        fprintf(stderr, "kernel_launch: grid %d (cus %d, per_cu %d)\n", grid, cus, per_cu);
    }
    if (grid < 0) return;
    Params p{};
    const float** pp = (const float**)&p;
    for (int i = 0; i < 17; ++i) pp[i] = (const float*)d_in[i];
    p.out = (float*)d_out; p.ws = (unsigned char*)d_ws;
#if MK_SINGLE
    p.ph_lo = 0; p.ph_hi = N_PHASES;
    void* args[] = {&p};
    hipError_t e = hipLaunchCooperativeKernel((const void*)hymba_mega, dim3(grid), dim3(512), args, LDS_BYTES, stream);
    if (e != hipSuccess) fprintf(stderr, "kernel_launch: cooperative launch failed: %s (grid %d)\n", hipGetErrorString(e), grid);
#else
    for (int ph = 0; ph < N_PHASES; ++ph) {
        p.ph_lo = ph; p.ph_hi = ph + 1;
        hipLaunchKernelGGL(hymba_mega, dim3(grid), dim3(512), LDS_BYTES, stream, p);
    }
#endif
}
```

```cpp
#include <hip/hip_runtime.h>
#include <hip/hip_cooperative_groups.h>
#include <cstdio>
namespace cg = cooperative_groups;
#ifndef MK_SINGLE
#define MK_SINGLE 1
#endif
namespace pg8 {
#define PG8_LAS __attribute__((address_space(3)))
typedef unsigned short bf16_t;
typedef short bf16x8 __attribute__((ext_vector_type(8)));
typedef float f32x4 __attribute__((ext_vector_type(4)));
typedef unsigned u32x4 __attribute__((ext_vector_type(4)));
constexpr int BM = 256, BK = 64, HALF = 128, HTB = HALF * BK * 2  , STAGE_BYTES = 8 * HTB, NXCD = 8, WGM = 4;

__host__ __device__ __forceinline__ int lds_byte(int r, int c) { const int st = (r >> 4) * 2 + (c >> 5), rr = r & 15, cc = c & 31, ob = rr * 64 + cc * 2; return st * 1024 + (ob ^ (((ob >> 9) & 1) << 5)); }
__host__ __device__ __forceinline__ void stage_rc(int b, int& R, int& C) { const int st = b / 1024, sb = b % 1024, swz = sb ^ (((sb >> 9) & 1) << 5); R = (st >> 1) * 16 + swz / 64; C = (st & 1) * 32 + (swz % 64) / 2; }
__host__ __device__ __forceinline__ int perm32(int rho) { const int n = rho >> 4, i = rho & 15; return 8 * (i >> 2) + 4 * n + (i & 3); }

struct Unit { int pm, pn; };
struct Gemm { const bf16_t* A; const bf16_t* Bt; int M, N, K; };

struct StaticOrder {
    int nM, nN, nwg, G, c;
    __host__ __device__ void init(int M, int N, int G_, int c_) { nM = M / BM; nN = N / BM; nwg = nM * nN; G = G_; c = c_; }
    __host__ __device__ bool next(int i, Unit& u) const {
        const long L = (long)i * G + c; if (L >= nwg) return false;
        int wgid = (int)L; { const int q = nwg / NXCD, r = nwg % NXCD, xcd = wgid % NXCD, off = wgid / NXCD; wgid = (xcd < r ? xcd * (q + 1) : r * (q + 1) + (xcd - r) * q) + off; }
        const int nig = WGM * nN, gid = wgid / nig, fm = gid * WGM, gsz = (nM - fm) < WGM ? (nM - fm) : WGM;
        u.pm = fm + ((wgid % nig) % gsz); u.pn = (wgid % nig) / gsz; return true;
    }
    __device__ __forceinline__ void a_ready(const Unit&) const {}
    __device__ __forceinline__ void done(const Unit&) const {}
};
__device__ __forceinline__ unsigned cvt_pk_bf16(float lo, float hi) { unsigned r; asm volatile("v_cvt_pk_bf16_f32 %0, %1, %2" : "=v"(r) : "v"(lo), "v"(hi)); return r; }
template <class Epi, class Sched, bool STAMP = false>
__device__ __forceinline__ void gemm_phase(PG8_LAS unsigned char* lds, const Gemm g, const Sched& S, const Epi& E, unsigned long long* stamps) {
    int tid_ = threadIdx.x; asm volatile("" : "+v"(tid_)); const int tid = tid_, wid = __builtin_amdgcn_readfirstlane(tid >> 6), lane = tid & 63, wr = wid >> 2, wc = wid & 3, fr = lane & 15, fq = lane >> 4;
    const int K = g.K, nt = K / BK;
    int ts_lo = 0, ts_hi = 0, nts = 0; const unsigned long long rt_entry = STAMP ? (unsigned long long)wall_clock64() : 0ull;
#define PG8_STAMP() do { if (STAMP && wid == 0 && nts < 64) { const unsigned long long _c = (unsigned long long)clock64(); \
        ts_lo = (lane == nts) ? (int)(unsigned)_c : ts_lo; ts_hi = (lane == nts) ? (int)(unsigned)(_c >> 32) : ts_hi; ++nts; } } while (0)
    PG8_STAMP();
    unsigned voffA[2], voffB[2];
#pragma unroll
    for (int i = 0; i < 2; ++i) { int R, C; stage_rc(tid * 16 + i * 8192, R, C); const int Rb = Epi::PERM ? ((R & ~31) + perm32(R & 31)) : R;
        voffA[i] = (unsigned)(R * K + C) * 2u; voffB[i] = (unsigned)(Rb * K + C) * 2u; }
    const size_t kstep = (size_t)(BK * 2);
    const size_t hstep = (size_t)HALF * K * 2;
    const size_t tstep = 2 * hstep;
    const unsigned ldsw = (unsigned)wid * 1024u;
    const int aoff = lds_byte(wr * 64 + fr, fq * 8), boff = lds_byte(wc * 32 + fr, fq * 8);
#define PG8_SA(b, h) (((b) * 2 + (h)) * HTB)
#define PG8_SB(b, h) ((4 + (b) * 2 + (h)) * HTB)
#define PG8_STAGE(bufoff, gbase, voff) do { _Pragma("unroll") for (int _i = 0; _i < 2; ++_i) \
        __builtin_amdgcn_global_load_lds((const unsigned*)((const char*)(gbase) + (voff)[_i]), (PG8_LAS unsigned*)(lds + (bufoff) + ldsw + _i * 8192), 16, 0, 0); } while (0)
#define PG8_LDA(dst, b, h) do { _Pragma("unroll") for (int m = 0; m < 4; ++m) _Pragma("unroll") for (int k = 0; k < 2; ++k) dst[m][k] = *(const PG8_LAS bf16x8*)(lds + PG8_SA(b, h) + aoff + m * 2048 + k * 1024); } while (0)
#define PG8_LDB(dst, b, h) do { _Pragma("unroll") for (int n = 0; n < 2; ++n) _Pragma("unroll") for (int k = 0; k < 2; ++k) dst[n][k] = *(const PG8_LAS bf16x8*)(lds + PG8_SB(b, h) + boff + n * 2048 + k * 1024); } while (0)
#define PG8_MMA(ai, bj, At, Bt) do { __builtin_amdgcn_s_setprio(1); _Pragma("unroll") for (int m = 0; m < 4; ++m) _Pragma("unroll") for (int n = 0; n < 2; ++n) _Pragma("unroll") for (int k = 0; k < 2; ++k) \
        acc[ai][bj][m][n] = __builtin_amdgcn_mfma_f32_16x16x32_bf16(Bt[n][k], At[m][k], acc[ai][bj][m][n], 0, 0, 0); __builtin_amdgcn_s_setprio(0); } while (0)
#define PG8_WAIT_V(n) asm volatile("s_waitcnt vmcnt(" #n ")" ::: "memory")
#define PG8_WAIT_L(n) asm volatile("s_waitcnt lgkmcnt(" #n ")" ::: "memory")
#define PG8_BAR __builtin_amdgcn_s_barrier()
#define PG8_SCHED __builtin_amdgcn_sched_barrier(0)
    Unit cur, nxt; int ui = 0;
    if (!S.next(0, cur)) return;
    f32x4 acc[2][2][4][2];
#pragma unroll
    for (int a = 0; a < 2; ++a)
#pragma unroll
        for (int b = 0; b < 2; ++b)
#pragma unroll
            for (int m = 0; m < 4; ++m)
#pragma unroll
                for (int n = 0; n < 2; ++n) acc[a][b][m][n] = (f32x4){0.f, 0.f, 0.f, 0.f};
    bf16x8 At[4][2], B0[2][2], B1[2][2];
    const char* cA = (const char*)g.A + (size_t)cur.pm * tstep; const char* cB = (const char*)g.Bt + (size_t)cur.pn * tstep;
    S.a_ready(cur);
    PG8_STAGE(PG8_SB(0, 0), cB, voffB); PG8_STAGE(PG8_SA(0, 0), cA, voffA); PG8_STAGE(PG8_SB(0, 1), cB + hstep, voffB); PG8_STAGE(PG8_SA(0, 1), cA + hstep, voffA);
    if (wr == 1) PG8_BAR;
    PG8_WAIT_V(4); PG8_BAR;
    PG8_STAGE(PG8_SB(1, 0), cB + kstep, voffB); PG8_STAGE(PG8_SA(1, 0), cA + kstep, voffA); PG8_STAGE(PG8_SB(1, 1), cB + hstep + kstep, voffB);
    PG8_WAIT_V(6); PG8_BAR;
    PG8_STAMP();
    for (;;) {
        const bool has_next = S.next(ui + 1, nxt);
        const char* nA = has_next ? (const char*)g.A + (size_t)nxt.pm * tstep : cA; const char* nB = has_next ? (const char*)g.Bt + (size_t)nxt.pn * tstep : cB;
        for (int t = 0; t < nt; t += 2) {
            const bool last = (t == nt - 2);
            const char* a1 = cA + (size_t)(t + 1) * kstep;
            const char* a2 = last ? nA : cA + (size_t)(t + 2) * kstep; const char* b2 = last ? nB : cB + (size_t)(t + 2) * kstep;
            const char* a3 = a2 + kstep; const char* b3 = b2 + kstep;
            if (last && has_next) S.a_ready(nxt);
            PG8_LDB(B0, 0, 0); PG8_SCHED; PG8_LDA(At, 0, 0); PG8_STAGE(PG8_SA(1, 1), a1 + hstep, voffA);
            PG8_WAIT_L(8); PG8_BAR; PG8_WAIT_L(0); PG8_MMA(0, 0, At, B0); PG8_BAR; PG8_SCHED;
            PG8_LDB(B1, 0, 1); PG8_STAGE(PG8_SB(0, 0), b2, voffB);
            PG8_BAR; PG8_WAIT_L(0); PG8_MMA(0, 1, At, B1); PG8_BAR;
            PG8_LDA(At, 0, 1); PG8_STAGE(PG8_SA(0, 0), a2, voffA);
            PG8_BAR; PG8_WAIT_L(0); PG8_MMA(1, 0, At, B0); PG8_BAR; PG8_SCHED;
            PG8_STAGE(PG8_SB(0, 1), b2 + hstep, voffB);
            PG8_WAIT_V(6); PG8_BAR; PG8_MMA(1, 1, At, B1); PG8_BAR;
            PG8_LDB(B0, 1, 0); PG8_SCHED; PG8_LDA(At, 1, 0); PG8_STAGE(PG8_SA(0, 1), a2 + hstep, voffA);
            PG8_WAIT_L(8); PG8_BAR; PG8_WAIT_L(0); PG8_MMA(0, 0, At, B0); PG8_BAR; PG8_SCHED;
            PG8_LDB(B1, 1, 1); PG8_STAGE(PG8_SB(1, 0), b3, voffB);
            PG8_BAR; PG8_WAIT_L(0); PG8_MMA(0, 1, At, B1); PG8_BAR;
            PG8_LDA(At, 1, 1); PG8_STAGE(PG8_SA(1, 0), a3, voffA);
            PG8_BAR; PG8_WAIT_L(0); PG8_MMA(1, 0, At, B0); PG8_BAR; PG8_SCHED;
            PG8_STAGE(PG8_SB(1, 1), b3 + hstep, voffB);
            PG8_WAIT_V(6); PG8_BAR; PG8_MMA(1, 1, At, B1); PG8_BAR;
        }
        PG8_STAMP();
        if constexpr (!Epi::AFTER_DRAIN) { E(acc, cur, wr, wc, fr, fq); S.done(cur); }
        PG8_STAMP();
        if (!has_next) break;
#pragma unroll
        for (int a = 0; a < 2; ++a)
#pragma unroll
            for (int b = 0; b < 2; ++b)
#pragma unroll
                for (int m = 0; m < 4; ++m)
#pragma unroll
                    for (int n = 0; n < 2; ++n) acc[a][b][m][n] = (f32x4){0.f, 0.f, 0.f, 0.f};
        cur = nxt; cA = nA; cB = nB; ++ui;
    }
    PG8_WAIT_V(0);
    if (wr == 0) PG8_BAR;
    PG8_BAR;
    if constexpr (Epi::AFTER_DRAIN) { E.fused(acc, cur, wr, wc, fr, fq, lds, wid, lane); S.done(cur); }
    PG8_STAMP();
    if (STAMP && wid == 0) { stamps[lane] = lane < nts ? (((unsigned long long)(unsigned)ts_hi << 32) | (unsigned)ts_lo) : 0ull;
        if (lane == 62) stamps[62] = rt_entry; if (lane == 63) stamps[63] = (unsigned long long)wall_clock64(); }
#undef PG8_STAMP
#undef PG8_SA
#undef PG8_SB
#undef PG8_STAGE
#undef PG8_LDA
#undef PG8_LDB
#undef PG8_MMA
#undef PG8_WAIT_V
#undef PG8_WAIT_L
#undef PG8_BAR
#undef PG8_SCHED
}
}

using pg8::bf16_t; using pg8::bf16x8; using pg8::f32x4; using pg8::u32x4;
typedef unsigned u32x2 __attribute__((ext_vector_type(2)));
#define DI __device__ __forceinline__
#define MFMA16(a, b, c) __builtin_amdgcn_mfma_f32_16x16x32_bf16((a), (b), (c), 0, 0, 0)

constexpr int D_ = 1024, SEQ_ = 4096, M_ = 32768, DIN_ = 6160, NPAD_ = 6400;
constexpr size_t PLANE_ = (size_t)M_ * 1024;
constexpr size_t OFF_WIN = 0;
constexpr size_t OFF_WOUT = OFF_WIN + (size_t)2 * NPAD_ * 1024 * 2;
constexpr size_t OFF_WG = OFF_WOUT + (size_t)2 * 1024 * 2048 * 2;
constexpr size_t OFF_XB = OFF_WG + (size_t)2 * 8 * 256 * 128 * 2;
constexpr size_t OFF_LRUX = OFF_XB + PLANE_ * 2;
constexpr size_t OFF_ZY = OFF_LRUX + PLANE_ * 2;
constexpr size_t OFF_QKV = OFF_ZY + PLANE_ * 4;
constexpr size_t OFF_HALO = OFF_QKV + PLANE_ * 6;
constexpr size_t OFF_BA = OFF_HALO + (size_t)3 * 4096 * 3 * 128 * 2;
constexpr size_t OFF_RSTD = OFF_BA + (size_t)M_ * 16 * 4;
constexpr size_t OFF_G = OFF_RSTD + (size_t)M_ * 4;
constexpr size_t OFF_GC = OFF_G + (size_t)M_ * 8 * 4;
constexpr size_t OFF_BETA = OFF_GC + (size_t)M_ * 8 * 4;
constexpr size_t OFF_AGG = OFF_BETA + (size_t)M_ * 8 * 4;
constexpr size_t OFF_BG = OFF_AGG + (size_t)8 * 64 * 1024 * 2 * 4;
constexpr size_t OFF_DL = OFF_BG + (size_t)M_ * 8 * 4;
constexpr size_t OFF_CTR = OFF_DL + (size_t)M_ * 8 * 4;
constexpr size_t WS_END = OFF_CTR + 8192;
constexpr int LDS_BYTES = 131072 + 16;
constexpr int N_PHASES = 11;

struct Params {
    const float *x, *norm_w, *w_in, *lru_conv_w, *lru_conv_b, *lru_wa, *lru_ba, *lru_wx, *lru_bx, *lru_lambda, *lru_norm_w,
        *dn_conv_w, *dn_A_log, *dn_dt_bias, *dn_norm_w, *w_out, *final_norm_w;
    float* out;
    unsigned char* ws;
    int ph_lo, ph_hi;
};

DI int otid() { int t = threadIdx.x; asm volatile("" : "+v"(t)); return t; }
typedef const __attribute__((address_space(4))) Params* CP;
DI bf16_t f2bf(float f) { unsigned u = __float_as_uint(f); u += 0x7FFFu + ((u >> 16) & 1u); return (bf16_t)(u >> 16); }
DI float bf2f(bf16_t b) { return __uint_as_float(((unsigned)b) << 16); }
typedef float f32x2_ __attribute__((ext_vector_type(2)));
typedef __bf16 bf16x2_ __attribute__((ext_vector_type(2)));
DI unsigned pkcvt(float lo, float hi) { f32x2_ v = {lo, hi}; bf16x2_ b = __builtin_convertvector(v, bf16x2_); return __builtin_bit_cast(unsigned, b); }
DI unsigned pk2(float lo, float hi) { return pkcvt(lo, hi); }
DI float sigmoidf_(float x) { return __builtin_amdgcn_rcpf(1.f + __expf(-x)); }
DI float softplusf_(float x) { return x > 20.f ? x : log1pf(__expf(x)); }
DI float softplus_fast(float x) { return x > 20.f ? x : __logf(1.f + __expf(x)); }
DI void unpack8(const u32x4 v, float* o) {
#pragma unroll
    for (int i = 0; i < 4; ++i) { o[2 * i] = __uint_as_float(v[i] << 16); o[2 * i + 1] = __uint_as_float(v[i] & 0xFFFF0000u); }
}

struct EpiIn {
    static constexpr bool PERM = true, AFTER_DRAIN = false;
    const float* rstd; unsigned char* ws;
    DI void operator()(const f32x4 (&acc)[2][2][4][2], const pg8::Unit& u, int wr, int wc, int fr, int fq) const {
        const int row0 = u.pm * 256 + wr * 64 + fr;
        const int pn = u.pn;
        if (pn == 24) {
            if (wc == 0 && fq < 2) {
                float* ba = (float*)(ws + OFF_BA) + (size_t)row0 * 16 + 8 * fq;
#pragma unroll
                for (int ai = 0; ai < 2; ++ai)
#pragma unroll
                    for (int m = 0; m < 4; ++m) {
                        const float s = 1.f;
#pragma unroll
                        for (int n = 0; n < 2; ++n) { f32x4 v = acc[ai][0][m][n] * s; *(f32x4*)(ba + (size_t)(ai * 128 + m * 16) * 16 + 4 * n) = v; }
                    }
            }
            return;
        }
        const int region = pn >> 2;
        const int colr = (pn & 3) * 256 + wc * 32 + 8 * fq;
        bf16_t* base; int SA, SB, SM; bf16_t* hbase = nullptr;
        if (region == 0) { base = (bf16_t*)(ws + OFF_LRUX) + (size_t)row0 * 1024 + colr; SA = 128 * 1024; SB = 128; SM = 16 * 1024; }
        else if (region == 1 || region == 5) { base = (bf16_t*)(ws + OFF_ZY) + (size_t)row0 * 2048 + colr + (region == 5 ? 1024 : 0); SA = 128 * 2048; SB = 128; SM = 16 * 2048; }
        else {
            const int pl = region - 2, h0 = (pn & 3) * 2, d = wc * 32 + 8 * fq, b = u.pm >> 4, n0 = (u.pm * 4 + wr) & 63;
            const int blk = (b * 8 + h0) * 64 + n0;
            base = (bf16_t*)(ws + OFF_QKV) + (size_t)pl * PLANE_ + ((size_t)blk * 64 + fr) * 128 + d; SA = 2 * 8192; SB = 64 * 8192; SM = 16 * 128;
            hbase = (bf16_t*)(ws + OFF_HALO) + (((size_t)pl * 4096 + blk) * 3 + (fr - 13)) * 128 + d;
        }
#pragma unroll
        for (int ai = 0; ai < 2; ++ai)
#pragma unroll
            for (int m = 0; m < 4; ++m) {
                const float s = 1.f;
#pragma unroll
                for (int bj = 0; bj < 2; ++bj) {
                    f32x4 v0 = acc[ai][bj][m][0] * s, v1 = acc[ai][bj][m][1] * s;
                    if (region == 1 || region == 5) {
#pragma unroll
                        for (int k = 0; k < 4; ++k) { v0[k] = v0[k] * sigmoidf_(v0[k]); v1[k] = v1[k] * sigmoidf_(v1[k]); }
                    }
                    u32x4 w; w[0] = pg8::cvt_pk_bf16(v0[0], v0[1]); w[1] = pg8::cvt_pk_bf16(v0[2], v0[3]); w[2] = pg8::cvt_pk_bf16(v1[0], v1[1]); w[3] = pg8::cvt_pk_bf16(v1[2], v1[3]);
                    *(u32x4*)(base + (size_t)ai * SA + (size_t)bj * SB + (size_t)m * SM) = w;
                    if (m == 3 && hbase != nullptr && fr >= 13) *(u32x4*)(hbase + ai * (2 * 384) + bj * (64 * 384)) = w;
                }
                asm volatile("" ::: "memory");
            }
    }
};
struct EpiOut {
    static constexpr bool PERM = false, AFTER_DRAIN = false;
    const float* res; float* out;
    DI void operator()(const f32x4 (&acc)[2][2][4][2], const pg8::Unit& u, int wr, int wc, int fr, int fq) const {
        const int row0 = u.pm * 256 + wr * 64 + fr, col0 = u.pn * 256 + wc * 32 + 4 * fq;
#pragma unroll
        for (int ai = 0; ai < 2; ++ai)
#pragma unroll
            for (int m = 0; m < 4; ++m) {
                const size_t ro = (size_t)(row0 + ai * 128 + m * 16) * 1024 + col0;
#pragma unroll
                for (int bj = 0; bj < 2; ++bj)
#pragma unroll
                    for (int n = 0; n < 2; ++n) { const f32x4 rv = *(const f32x4*)(res + ro + bj * 128 + n * 16); *(f32x4*)(out + ro + bj * 128 + n * 16) = rv + acc[ai][bj][m][n]; }
            }
    }
};

struct TileDesc { const float* src; const float* scale; bf16_t* dst; int src_ld, C, dst_ld, r0, c0; };
DI TileDesc prep_tile(CP p, int idx) {
    bf16_t* WinT = (bf16_t*)(p->ws + OFF_WIN); bf16_t* WoutT = (bf16_t*)(p->ws + OFF_WOUT); bf16_t* WgT = (bf16_t*)(p->ws + OFF_WG);
    TileDesc d;
    if (idx < 3200) {
        const int l = idx / 1600, t = idx % 1600, rt = t / 100, ct = t % 100;
        d.src = p->w_in + (size_t)l * 1024 * DIN_; d.src_ld = DIN_; d.C = DIN_; d.scale = p->norm_w + l * 1024; d.dst = WinT + (size_t)l * NPAD_ * 1024; d.dst_ld = 1024; d.r0 = rt * 64; d.c0 = ct * 64;
    } else if (idx < 4224) {
        const int j = idx - 3200, l = j / 512, t = j % 512, rt = t / 16, ct = t % 16;
        d.src = p->w_out + (size_t)l * 2048 * 1024; d.src_ld = 1024; d.C = 1024; d.scale = nullptr; d.dst = WoutT + (size_t)l * 1024 * 2048; d.dst_ld = 2048; d.r0 = rt * 64; d.c0 = ct * 64;
    } else {
        const int j = idx - 4224, l = j / 64, g = (j / 32) & 1, h = (j / 4) & 7, tt = j & 3, rt = tt >> 1, ct = tt & 1;
        d.src = (g ? p->lru_wx : p->lru_wa) + (size_t)(l * 8 + h) * 128 * 128; d.src_ld = 128; d.C = 128; d.scale = nullptr; d.dst = WgT + ((size_t)(l * 8 + h) * 256 + g * 128) * 128; d.dst_ld = 128; d.r0 = rt * 64; d.c0 = ct * 64;
    }
    return d;
}
DI void prep_load(const TileDesc& d, int tid, float4 (&v)[2]) {
#pragma unroll
    for (int i = 0; i < 2; ++i) {
        const int e = tid + 512 * i, rr = e >> 4, c4 = (e & 15) * 4; v[i] = make_float4(0.f, 0.f, 0.f, 0.f);
        if (d.c0 + c4 < d.C) { v[i] = *(const float4*)(d.src + (size_t)(d.r0 + rr) * d.src_ld + d.c0 + c4); if (d.scale) { const float sc = d.scale[d.r0 + rr]; v[i].x *= sc; v[i].y *= sc; v[i].z *= sc; v[i].w *= sc; } }
    }
}
DI void prep_phase(CP p, unsigned char* shm) {
    float* lds = (float*)shm;
    const int tid = otid();
    if ((int)blockIdx.x >= 4352) return;
    float4 v[2];
    TileDesc cur = prep_tile(p, blockIdx.x);
    prep_load(cur, tid, v);
    for (int idx = blockIdx.x; idx < 4352; idx += gridDim.x) {
#pragma unroll
        for (int i = 0; i < 2; ++i) { const int e = tid + 512 * i, rr = e >> 4, c4 = (e & 15) * 4; lds[rr * 65 + c4] = v[i].x; lds[rr * 65 + c4 + 1] = v[i].y; lds[rr * 65 + c4 + 2] = v[i].z; lds[rr * 65 + c4 + 3] = v[i].w; }
        __syncthreads();
        const TileDesc done = cur;
        if (idx + (int)gridDim.x < 4352) { cur = prep_tile(p, idx + gridDim.x); prep_load(cur, tid, v); }
        {
            const int cc = tid >> 3, r8 = (tid & 7) * 8; u32x4 wv;
#pragma unroll
            for (int e = 0; e < 4; ++e) wv[e] = pk2(lds[(r8 + 2 * e) * 65 + cc], lds[(r8 + 2 * e + 1) * 65 + cc]);
            *(u32x4*)(done.dst + (size_t)(done.c0 + cc) * done.dst_ld + done.r0 + r8) = wv;
        }
        __syncthreads();
    }
}
DI void rownorm_phase(const float* src, bf16_t* xb, float* rstd, const float* fw, float* dst) {
    const int tid = otid(); const int lane = tid & 63, wave = blockIdx.x * 8 + (tid >> 6), nw = gridDim.x * 8;
    for (int row = wave; row < M_; row += nw) {
        const float4* sp = (const float4*)(src + (size_t)row * 1024);
        float4 v[4]; float ss = 0.f;
#pragma unroll
        for (int i = 0; i < 4; ++i) { v[i] = sp[lane + 64 * i]; ss += v[i].x * v[i].x + v[i].y * v[i].y + v[i].z * v[i].z + v[i].w * v[i].w; }
#pragma unroll
        for (int o = 32; o >= 1; o >>= 1) ss += __shfl_xor(ss, o);
        const float r = __builtin_amdgcn_rsqf(ss * (1.f / 1024.f) + 1e-6f);
        if (fw) {
#pragma unroll
            for (int i = 0; i < 4; ++i) { const float4 w4 = ((const float4*)fw)[lane + 64 * i]; float4 o4; o4.x = v[i].x * r * w4.x; o4.y = v[i].y * r * w4.y; o4.z = v[i].z * r * w4.z; o4.w = v[i].w * r * w4.w; ((float4*)(dst + (size_t)row * 1024))[lane + 64 * i] = o4; }
        } else {
            if (lane == 0) rstd[row] = r;
#pragma unroll
            for (int i = 0; i < 4; ++i) { u32x2 w; w[0] = pk2(v[i].x * r, v[i].y * r); w[1] = pk2(v[i].z * r, v[i].w * r); *(u32x2*)(xb + (size_t)row * 1024 + 4 * (lane + 64 * i)) = w; }
        }
    }
}

DI void lru_phase(CP p, int l, int pass, int first, int stride, unsigned char* lds) {
    const int tid = otid(), lane = tid & 63, w = tid >> 6, q = lane >> 4, fr = lane & 15;
    const int h = first & 7;
    float* xcf = (float*)lds;
    bf16_t* xcb = (bf16_t*)(lds + 33792);
    float* ssq_s = (float*)(lds + 51200);
    float* tot_s = (float*)(lds + 53248);
    bf16_t* zt = (bf16_t*)(lds + 53504);
    float* cw = (float*)(lds + 70912);
    const bf16_t* lrux = (const bf16_t*)(p->ws + OFF_LRUX);
    bf16_t* zy = (bf16_t*)(p->ws + OFF_ZY);
    float2* agg = (float2*)(p->ws + OFF_AGG);
    if (first >= 4096) return;
    for (int e = tid; e < 640; e += 512) cw[e] = e < 512 ? p->lru_conv_w[(size_t)(l * 4 + (e >> 7)) * 1024 + h * 128 + (e & 127)] : p->lru_conv_b[l * 1024 + h * 128 + (e & 127)];
    const int j = 16 * w + fr, chj = h * 128 + j;
    const float ba_j = p->lru_ba[l * 1024 + chj], bx_j = p->lru_bx[l * 1024 + chj];
    const float sp8 = -8.f * softplusf_(-p->lru_lambda[l * 1024 + chj]);
    const float nwj = p->lru_norm_w[l * 1024 + chj];
    bf16x8 wfa[4], wfx[4];
    const bf16_t* wg = (const bf16_t*)(p->ws + OFF_WG) + (size_t)(l * 8 + h) * 256 * 128;
    if (pass == 1) {
#pragma unroll
        for (int ks = 0; ks < 4; ++ks) { wfa[ks] = *(const bf16x8*)(wg + (size_t)(16 * w + fr) * 128 + 32 * ks + 8 * q); wfx[ks] = *(const bf16x8*)(wg + (size_t)(128 + 16 * w + fr) * 128 + 32 * ks + 8 * q); }
    }
    const int t = tid >> 3, cg8 = tid & 7, ch = h * 128 + cg8 * 16;
    u32x4 xr[8], zr[2];
#define LRU_LOAD(item_) do { const int n_ = ((item_) >> 3) & 63, b_ = (item_) >> 9; \
        _Pragma("unroll") for (int j_ = 0; j_ < 4; ++j_) { const int tt_ = n_ * 64 + t - 3 + j_; \
            if (tt_ >= 0) { const bf16_t* sp_ = lrux + ((size_t)b_ * 4096 + tt_) * 1024 + ch; xr[2 * j_] = *(const u32x4*)sp_; xr[2 * j_ + 1] = *(const u32x4*)(sp_ + 8); } \
            else { xr[2 * j_] = (u32x4){0, 0, 0, 0}; xr[2 * j_ + 1] = (u32x4){0, 0, 0, 0}; } } \
        if (pass == 2) { _Pragma("unroll") for (int i_ = 0; i_ < 2; ++i_) { const int e_ = tid + 512 * i_; \
            zr[i_] = *(const u32x4*)(zy + ((size_t)b_ * 4096 + n_ * 64 + (e_ >> 4)) * 2048 + h * 128 + (e_ & 15) * 8); } } } while (0)
#define LRU_AGG_LOAD(item_) do { const int n_ = ((item_) >> 3) & 63, b_ = (item_) >> 9; \
        _Pragma("unroll") for (int k_ = 0; k_ < 16; ++k_) { const int nn_ = 16 * q + k_; ag[k_] = (nn_ < n_) ? agg[((size_t)b_ * 64 + nn_) * 1024 + chj] : make_float2(1.f, 0.f); } } while (0)
#define LRU_AGG_FOLD() do { float Ap_ = 1.f, Hp_ = 0.f; \
        _Pragma("unroll") for (int k_ = 0; k_ < 16; ++k_) { Hp_ = ag[k_].x * Hp_ + ag[k_].y; Ap_ *= ag[k_].x; } \
        carry_next = 0.f; \
        _Pragma("unroll") for (int qq_ = 0; qq_ < 4; ++qq_) { const float a2_ = __shfl(Ap_, fr + 16 * qq_), h2_ = __shfl(Hp_, fr + 16 * qq_); carry_next = a2_ * carry_next + h2_; } } while (0)
    float carry_next = 0.f;
    float2 ag[16];
    if (pass == 2) { LRU_AGG_LOAD(first); LRU_AGG_FOLD(); }
    LRU_LOAD(first);
    __syncthreads();
    for (int item = first; item < 4096; item += stride) {
        const int n = (item >> 3) & 63, b = item >> 9;
        const size_t t0 = (size_t)b * 4096 + (size_t)n * 64;
        {
            float a[16];
#pragma unroll
            for (int e = 0; e < 16; e += 4) { const float4 b4 = *(const float4*)(cw + 512 + cg8 * 16 + e); a[e] = b4.x; a[e + 1] = b4.y; a[e + 2] = b4.z; a[e + 3] = b4.w; }
#pragma unroll
            for (int jj = 0; jj < 4; ++jj) {
                float xv[16]; unpack8(xr[2 * jj], xv); unpack8(xr[2 * jj + 1], xv + 8);
#pragma unroll
                for (int e = 0; e < 16; e += 4) { const float4 w4 = *(const float4*)(cw + jj * 128 + cg8 * 16 + e); a[e] += w4.x * xv[e]; a[e + 1] += w4.y * xv[e + 1]; a[e + 2] += w4.z * xv[e + 2]; a[e + 3] += w4.w * xv[e + 3]; }
            }
#pragma unroll
            for (int e = 0; e < 16; e += 4) *(float4*)(xcf + t * 132 + cg8 * 16 + e) = make_float4(a[e], a[e + 1], a[e + 2], a[e + 3]);
            u32x4 w0, w1;
#pragma unroll
            for (int e = 0; e < 4; ++e) { w0[e] = pk2(a[2 * e], a[2 * e + 1]); w1[e] = pk2(a[8 + 2 * e], a[8 + 2 * e + 1]); }
            *(u32x4*)(xcb + t * 136 + cg8 * 16) = w0; *(u32x4*)(xcb + t * 136 + cg8 * 16 + 8) = w1;
            if (pass == 2) {
#pragma unroll
                for (int i = 0; i < 2; ++i) { const int e = tid + 512 * i; *(u32x4*)(zt + (e >> 4) * 136 + (e & 15) * 8) = zr[i]; }
            }
        }
        if (pass == 1 && item + stride < 4096) LRU_LOAD(item + stride);
        __syncthreads();
        f32x4 ga[4], gx[4];
#pragma unroll
        for (int m = 0; m < 4; ++m) { ga[m] = (f32x4){0.f, 0.f, 0.f, 0.f}; gx[m] = (f32x4){0.f, 0.f, 0.f, 0.f}; }
        __builtin_amdgcn_s_setprio(1);
#pragma unroll
        for (int ks = 0; ks < 4; ++ks) {
            if (pass == 2) { wfa[ks] = *(const bf16x8*)(wg + (size_t)(16 * w + fr) * 128 + 32 * ks + 8 * q); wfx[ks] = *(const bf16x8*)(wg + (size_t)(128 + 16 * w + fr) * 128 + 32 * ks + 8 * q); }
#pragma unroll
            for (int m = 0; m < 4; ++m) {
                const bf16x8 a_ = *(const bf16x8*)(xcb + (16 * m + fr) * 136 + 32 * ks + 8 * q);
                ga[m] = MFMA16(a_, wfa[ks], ga[m]); gx[m] = MFMA16(a_, wfx[ks], gx[m]);
            }
        }
        __builtin_amdgcn_s_setprio(0);
        float av[4][4], bv[4][4], A_[4], H_[4];
#pragma unroll
        for (int m = 0; m < 4; ++m) {
            float Aa = 1.f, Hh = 0.f;
#pragma unroll
            for (int i = 0; i < 4; ++i) {
                const int tt = 16 * m + 4 * q + i;
                const float r = sigmoidf_(ga[m][i] + ba_j), ig = sigmoidf_(gx[m][i] + bx_j);
                const float la = sp8 * r, a = __expf(la), mult = __builtin_amdgcn_sqrtf(fmaxf(1.f - a * a, 0.f));
                const float bb = mult * ig * xcf[tt * 132 + j];
                av[m][i] = a; bv[m][i] = bb; Hh = a * Hh + bb; Aa *= a;
            }
            A_[m] = Aa; H_[m] = Hh;
        }
        if (pass == 1) {
            float At = 1.f, Ht = 0.f;
#pragma unroll
            for (int m = 0; m < 4; ++m)
#pragma unroll
                for (int qq = 0; qq < 4; ++qq) { const float a2 = __shfl(A_[m], fr + 16 * qq), h2 = __shfl(H_[m], fr + 16 * qq); Ht = a2 * Ht + h2; At *= a2; }
            if (q == 0) agg[((size_t)b * 64 + n) * 1024 + chj] = make_float2(At, Ht);
            __syncthreads();
            continue;
        }
        float carry = carry_next;
        float hv[4][4];
#pragma unroll
        for (int m = 0; m < 4; ++m) {
            float hs = carry;
#pragma unroll
            for (int qq = 0; qq < 4; ++qq) {
                const float a2 = __shfl(A_[m], fr + 16 * qq), h2 = __shfl(H_[m], fr + 16 * qq);
                if (qq < q) hs = a2 * hs + h2;
                carry = a2 * carry + h2;
            }
#pragma unroll
            for (int i = 0; i < 4; ++i) { hs = av[m][i] * hs + bv[m][i]; hv[m][i] = hs; }
        }
        if (item + stride < 4096) LRU_LOAD(item + stride);
#pragma unroll
        for (int m = 0; m < 4; ++m)
#pragma unroll
            for (int i = 0; i < 4; ++i) {
                float sq = hv[m][i] * hv[m][i];
                sq += __shfl_xor(sq, 1); sq += __shfl_xor(sq, 2); sq += __shfl_xor(sq, 4); sq += __shfl_xor(sq, 8);
                if (fr == 0) ssq_s[w * 64 + 16 * m + 4 * q + i] = sq;
            }
        __syncthreads();
        if (tid < 64) { float t_ = 0.f;
#pragma unroll
            for (int ww = 0; ww < 8; ++ww) t_ += ssq_s[ww * 64 + tid];
            tot_s[tid] = __builtin_amdgcn_rsqf(t_ * (1.f / 128.f) + 1e-6f); }
        __syncthreads();
#pragma unroll
        for (int m = 0; m < 4; ++m)
#pragma unroll
            for (int i = 0; i < 4; ++i) {
                const int tt = 16 * m + 4 * q + i;
                const float z = bf2f(zt[tt * 136 + j]);
                zt[tt * 136 + j] = (bf16_t)(pkcvt(hv[m][i] * tot_s[tt] * nwj * z, 0.f) & 0xFFFFu);
            }
        __syncthreads();
#pragma unroll
        for (int i = 0; i < 2; ++i) { const int e = tid + 512 * i; *(u32x4*)(zy + (t0 + (e >> 4)) * 2048 + h * 128 + (e & 15) * 8) = *(const u32x4*)(zt + (e >> 4) * 136 + (e & 15) * 8); }
        if (item + stride < 4096) { LRU_AGG_LOAD(item + stride); LRU_AGG_FOLD(); }
        __syncthreads();
    }
#undef LRU_AGG_LOAD
#undef LRU_AGG_FOLD
#undef LRU_LOAD
}

DI void dn_local_phase(CP p, int l, unsigned char* lds, unsigned long long& g_tsec) {
    const int tid0 = otid();
    const int h = blockIdx.x & 7, wg_h = blockIdx.x >> 3, n_wg_h = gridDim.x >> 3;
    bf16_t* qt = (bf16_t*)lds;
    bf16_t* kt = (bf16_t*)(lds + 17408);
    bf16_t* raw = (bf16_t*)(lds + 34816);
    float* As = (float*)(lds + 34816);
    float* Xs = (float*)(lds + 51456);
    float* Bs = (float*)(lds + 72000);
    float* g_s = (float*)(lds + 89600);
    float* gc_s = g_s + 64; float* beta_s = g_s + 128;
    float* cwl = (float*)(lds + 90368);
    bf16_t* vts = (bf16_t*)(lds + 96512);
    bf16_t* ats = (bf16_t*)(lds + 114944);
    bf16_t* qkv = (bf16_t*)(p->ws + OFF_QKV);
    const bf16_t* halo = (const bf16_t*)(p->ws + OFF_HALO);
    const float* ba = (const float*)(p->ws + OFF_BA);
    (void)gc_s;
    if (wg_h >= 512) return;
    for (int e = tid0; e < 1536; e += 512) { const int pl = e >> 9, j = (e >> 7) & 3, d = e & 127; cwl[e] = p->dn_conv_w[(size_t)(l * 4 + j) * 3072 + pl * 1024 + h * 128 + d]; }
    const float aexp = -__expf(p->dn_A_log[l * 8 + h]), dtb = p->dn_dt_bias[l * 8 + h];
    u32x4 rr_[7];
#define DNL_LOAD(item_) do { const int n_ = (item_) & 63; \
        _Pragma("unroll") for (int i_ = 0; i_ < 7; ++i_) { const int e_ = tid + 512 * i_; const int pl_ = e_ / 1072, rem_ = e_ - pl_ * 1072, r_ = rem_ >> 4, c8_ = (rem_ & 15) * 8; \
            rr_[i_] = (u32x4){0u, 0u, 0u, 0u}; \
            if (e_ < 3216) { if (r_ >= 3) rr_[i_] = *(const u32x4*)(qkv + (size_t)pl_ * PLANE_ + (size_t)(item_) * 8192 + (r_ - 3) * 128 + c8_); \
                             else if (n_ > 0) rr_[i_] = *(const u32x4*)(halo + (((size_t)pl_ * 4096 + ((item_) - 1)) * 3 + r_) * 128 + c8_); } } } while (0)
    {
        const int tid = tid0;
        const int b0 = wg_h >> 6, n0 = wg_h & 63;
        DNL_LOAD((b0 * 8 + h) * 64 + n0);
    }
    for (int rest = wg_h; rest < 512; rest += n_wg_h) {
    int tid_ = tid0; asm volatile("" : "+v"(tid_));
    const int tid = tid_, lane = tid & 63, w = tid >> 6, q = lane >> 4, fr = lane & 15;
    const int b = rest >> 6, n = rest & 63, item = (b * 8 + h) * 64 + n;
#ifdef TS_SEC
    unsigned long long tq0_ = wall_clock64();
#endif
    bf16_t* ta = (bf16_t*)(p->ws + OFF_XB) + (size_t)item * 8192;
#pragma unroll
    for (int i = 0; i < 7; ++i) { const int e = tid + 512 * i; const int pl = e / 1072, rem = e - pl * 1072; if (e < 3216) *(u32x4*)(raw + (pl * 67 + (rem >> 4)) * 136 + (rem & 15) * 8) = rr_[i]; }
    __syncthreads();
    if (rest + n_wg_h < 512) { const int r2 = rest + n_wg_h; DNL_LOAD((((r2 >> 6) * 8 + h) * 64 + (r2 & 63))); }
    const int t = tid >> 3, cg8 = tid & 7, d0 = cg8 * 16;
    const size_t tok = (size_t)b * 4096 + (size_t)n * 64 + t;
    const float beta = sigmoidf_(ba[tok * 16 + h]);
    const float g = aexp * softplus_fast(ba[tok * 16 + 8 + h] + dtb);
    float val[3][16];
#pragma unroll
    for (int pl = 0; pl < 3; ++pl) {
        float a[16];
#pragma unroll
        for (int e = 0; e < 16; ++e) a[e] = 0.f;
#pragma unroll
        for (int j = 0; j < 4; ++j) {
            const bf16_t* sp = raw + (pl * 67 + t + j) * 136 + d0;
            float xv[16]; unpack8(*(const u32x4*)sp, xv); unpack8(*(const u32x4*)(sp + 8), xv + 8);
            const float* wp = cwl + (pl * 4 + j) * 128 + d0;
#pragma unroll
            for (int e = 0; e < 16; e += 4) { const float4 w4 = *(const float4*)(wp + e); a[e] += w4.x * xv[e]; a[e + 1] += w4.y * xv[e + 1]; a[e + 2] += w4.z * xv[e + 2]; a[e + 3] += w4.w * xv[e + 3]; }
        }
        float ss = 0.f;
#pragma unroll
        for (int e = 0; e < 16; ++e) { a[e] = a[e] * sigmoidf_(a[e]); ss += a[e] * a[e]; }
        if (pl < 2) {
            ss += __shfl_xor(ss, 1); ss += __shfl_xor(ss, 2); ss += __shfl_xor(ss, 4);
            const float sc = __builtin_amdgcn_rsqf(ss + 1e-6f) * (pl == 0 ? 0.08838834764831845f : 1.f);
#pragma unroll
            for (int e = 0; e < 16; ++e) a[e] *= sc;
        } else {
#pragma unroll
            for (int e = 0; e < 16; ++e) a[e] *= beta;
        }
#pragma unroll
        for (int e = 0; e < 16; ++e) val[pl][e] = a[e];
    }
    u32x4 qw0, qw1, kw0, kw1;
#pragma unroll
    for (int e = 0; e < 4; ++e) { qw0[e] = pk2(val[0][2 * e], val[0][2 * e + 1]); qw1[e] = pk2(val[0][8 + 2 * e], val[0][9 + 2 * e]); kw0[e] = pk2(val[1][2 * e], val[1][2 * e + 1]); kw1[e] = pk2(val[1][8 + 2 * e], val[1][9 + 2 * e]); }
    *(u32x4*)(qt + t * 136 + d0) = qw0; *(u32x4*)(qt + t * 136 + d0 + 8) = qw1;
    *(u32x4*)(kt + t * 136 + d0) = kw0; *(u32x4*)(kt + t * 136 + d0 + 8) = kw1;
    if (cg8 == 0) { g_s[t] = g; beta_s[t] = beta; }
    __syncthreads();
    for (int e = tid; e < 64 * 65; e += 512) Xs[e] = 0.f;
#ifdef TS_SEC
    { const unsigned long long tq_ = wall_clock64(); if (TS_SEC == 2 && l == 0) g_tsec += tq_ - tq0_; tq0_ = tq_; }
#endif
    {
        bf16_t* qb = qkv + (size_t)item * 8192; bf16_t* kb = qkv + PLANE_ + (size_t)item * 8192; bf16_t* vb = qkv + 2 * PLANE_ + (size_t)item * 8192;
        *(u32x4*)(qb + t * 128 + d0) = qw0; *(u32x4*)(qb + t * 128 + d0 + 8) = qw1;
        *(u32x4*)(kb + t * 128 + d0) = kw0; *(u32x4*)(kb + t * 128 + d0 + 8) = kw1;
        (void)vb;
#pragma unroll
        for (int e = 0; e < 16; e += 2) { const unsigned pk_ = pk2(val[2][e], val[2][e + 1]); vts[(d0 + e) * 72 + t] = (bf16_t)(pk_ & 0xFFFFu); vts[(d0 + e + 1) * 72 + t] = (bf16_t)(pk_ >> 16); }
    }
    float gcl;
    {
        float v = g_s[lane];
#pragma unroll
        for (int o = 1; o < 64; o <<= 1) { const float u = __shfl_up(v, o); if (lane >= o) v += u; }
        gcl = v;
        if (w == 0) {
            const size_t gi = (size_t)(b * 8 + h) * 4096 + n * 64 + lane;
            const float eg_ = __expf(v), gl_ = __shfl(v, 63);
            ((float*)(p->ws + OFF_G))[gi] = g_s[lane]; ((float*)(p->ws + OFF_GC))[gi] = eg_; ((float*)(p->ws + OFF_BETA))[gi] = beta_s[lane];
            ((float*)(p->ws + OFF_BG))[gi] = beta_s[lane] * eg_; ((float*)(p->ws + OFF_DL))[gi] = __expf(gl_ - v);
        }
    }
    {
        const int mat = w >> 2, mt = w & 3;
        const bf16_t* at = mat ? qt : kt;
        f32x4 c4[4];
#pragma unroll
        for (int nt = 0; nt < 4; ++nt) c4[nt] = (f32x4){0.f, 0.f, 0.f, 0.f};
#pragma unroll
        for (int ks = 0; ks < 4; ++ks) {
            const bf16x8 a_ = *(const bf16x8*)(at + (16 * mt + fr) * 136 + 32 * ks + 8 * q);
#pragma unroll
            for (int nt = 0; nt < 4; ++nt) { const bf16x8 b_ = *(const bf16x8*)(kt + (16 * nt + fr) * 136 + 32 * ks + 8 * q); c4[nt] = MFMA16(a_, b_, c4[nt]); }
        }
        float gcc[4], gcj[4];
#pragma unroll
        for (int i = 0; i < 4; ++i) { gcc[i] = __shfl(gcl, 16 * mt + 4 * q + i); gcj[i] = __shfl(gcl, 16 * i + fr); }
#pragma unroll
        for (int nt = 0; nt < 4; ++nt)
#pragma unroll
            for (int i = 0; i < 4; ++i) {
                const int c = 16 * mt + 4 * q + i, jj = 16 * nt + fr;
                const float dec = __expf(fminf(gcc[i] - gcj[nt], 0.f));
                if (mat == 0) As[c * 65 + jj] = (jj < c) ? beta_s[c] * c4[nt][i] * dec : 0.f;
                else ats[c * 72 + jj] = (bf16_t)(pk2((jj <= c) ? c4[nt][i] * dec : 0.f, 0.f) & 0xFFFFu);
            }
    }
    __syncthreads();
    {
        bf16_t* vbg = qkv + 2 * PLANE_ + (size_t)item * 8192;
#pragma unroll
        for (int i = 0; i < 2; ++i) { const int e = tid + 512 * i; *(u32x4*)(vbg + (e >> 3) * 64 + (e & 7) * 8) = *(const u32x4*)(vts + (e >> 3) * 72 + (e & 7) * 8); }
        *(u32x4*)(ta + 4096 + (tid >> 3) * 64 + (tid & 7) * 8) = *(const u32x4*)(ats + (tid >> 3) * 72 + (tid & 7) * 8);
    }
#ifdef TS_SEC
    { const unsigned long long tq_ = wall_clock64(); if (TS_SEC == 3 && l == 0) g_tsec += tq_ - tq0_; tq0_ = tq_; }
#endif
    if (tid < 64) {
        const int b4 = tid >> 4, cc = tid & 15;
        float xx[16];
#pragma unroll
        for (int i = 0; i < 16; ++i) {
            float s = (i == cc) ? 1.f : 0.f;
#pragma unroll
            for (int jj = 0; jj < i; ++jj) s -= As[(b4 * 16 + i) * 65 + b4 * 16 + jj] * xx[jj];
            xx[i] = s;
        }
#pragma unroll
        for (int i = 0; i < 16; ++i) Xs[(b4 * 16 + i) * 65 + b4 * 16 + cc] = xx[i];
    }
    __syncthreads();
#define MFMA_F32(a, b, c) __builtin_amdgcn_mfma_f32_16x16x4f32((a), (b), (c), 0, 0, 0)
    if (w < 6) {
        const int r = w == 0 ? 1 : (w < 3 ? 2 : 3), cb = w == 0 ? 0 : (w < 3 ? w - 1 : w - 3), wd = 16 * r;
        f32x4 acc0 = (f32x4){0.f, 0.f, 0.f, 0.f}, acc1 = (f32x4){0.f, 0.f, 0.f, 0.f};
#pragma unroll
        for (int sk = 0; sk < 4; sk += 2) {
            acc0 = MFMA_F32(Xs[(wd + fr) * 65 + wd + 4 * sk + q], As[(wd + 4 * sk + q) * 65 + 16 * cb + fr], acc0);
            acc1 = MFMA_F32(Xs[(wd + fr) * 65 + wd + 4 * (sk + 1) + q], As[(wd + 4 * (sk + 1) + q) * 65 + 16 * cb + fr], acc1);
        }
#pragma unroll
        for (int i = 0; i < 4; ++i) Bs[((r - 1) * 16 + 4 * q + i) * 49 + 16 * cb + fr] = -(acc0[i] + acc1[i]);
    }
    __syncthreads();
#pragma unroll
    for (int r = 1; r < 4; ++r) {
        const int wd = 16 * r;
        if (w < r) {
            const int cb = w;
            f32x4 acc0 = (f32x4){0.f, 0.f, 0.f, 0.f}, acc1 = (f32x4){0.f, 0.f, 0.f, 0.f};
#pragma unroll
            for (int sk = 0; sk < 4 * r; sk += 2) {
                if (sk >= 4 * cb) {
                    acc0 = MFMA_F32(Bs[((r - 1) * 16 + fr) * 49 + 4 * sk + q], Xs[(4 * sk + q) * 65 + 16 * cb + fr], acc0);
                    acc1 = MFMA_F32(Bs[((r - 1) * 16 + fr) * 49 + 4 * (sk + 1) + q], Xs[(4 * (sk + 1) + q) * 65 + 16 * cb + fr], acc1);
                }
            }
#pragma unroll
            for (int i = 0; i < 4; ++i) Xs[(wd + 4 * q + i) * 65 + 16 * cb + fr] = acc0[i] + acc1[i];
        }
        __syncthreads();
    }
#undef MFMA_F32
#ifdef TS_SEC
    { const unsigned long long tq_ = wall_clock64(); if (TS_SEC == 4 && l == 0) g_tsec += tq_ - tq0_; tq0_ = tq_; }
#endif
    {
        const int row = tid >> 3, c8 = (tid & 7) * 8; u32x4 wv;
#pragma unroll
        for (int e = 0; e < 4; ++e) wv[e] = pk2(Xs[row * 65 + c8 + 2 * e], Xs[row * 65 + c8 + 2 * e + 1]);
        *(u32x4*)(ta + row * 64 + c8) = wv;
    }
    __syncthreads();
    }
#undef DNL_LOAD
}

DI void dn_out_tile(CP p, int l, int bh, int n, const float* o_tile, const bool have_z = false, const u32x4 z0 = (u32x4){0, 0, 0, 0}, const u32x4 z1 = (u32x4){0, 0, 0, 0}) {
    const int tid = otid(), t = tid >> 3, d0 = (tid & 7) * 16, b = bh >> 3, h = bh & 7;
    float o[16]; float ss = 0.f;
#pragma unroll
    for (int e = 0; e < 16; e += 4) { const float4 v = *(const float4*)(o_tile + t * 132 + d0 + e); o[e] = v.x; o[e + 1] = v.y; o[e + 2] = v.z; o[e + 3] = v.w; }
#pragma unroll
    for (int e = 0; e < 16; ++e) ss += o[e] * o[e];
    ss += __shfl_xor(ss, 1); ss += __shfl_xor(ss, 2); ss += __shfl_xor(ss, 4);
    const float r = __builtin_amdgcn_rsqf(ss * (1.f / 128.f) + 1e-6f);
    bf16_t* zp = (bf16_t*)(p->ws + OFF_ZY) + ((size_t)b * 4096 + (size_t)n * 64 + t) * 2048 + 1024 + h * 128 + d0;
    float z[16];
    if (have_z) { unpack8(z0, z); unpack8(z1, z + 8); } else { unpack8(*(const u32x4*)zp, z); unpack8(*(const u32x4*)(zp + 8), z + 8); }
    const float* nw = p->dn_norm_w + l * 128 + d0;
    float y[16];
#pragma unroll
    for (int e = 0; e < 16; e += 4) { const float4 w4 = *(const float4*)(nw + e); y[e] = o[e] * r * w4.x * z[e]; y[e + 1] = o[e + 1] * r * w4.y * z[e + 1]; y[e + 2] = o[e + 2] * r * w4.z * z[e + 2]; y[e + 3] = o[e + 3] * r * w4.w * z[e + 3]; }
    u32x4 w0, w1;
#pragma unroll
    for (int e = 0; e < 4; ++e) { w0[e] = pk2(y[2 * e], y[2 * e + 1]); w1[e] = pk2(y[8 + 2 * e], y[9 + 2 * e]); }
    *(u32x4*)zp = w0; *(u32x4*)(zp + 8) = w1;
}

DI void dn_seq_naive(CP p, int l, int bh, unsigned char* lds) {
    const int tid = otid(), r = tid >> 7, e = tid & 127;
    float* k_s = (float*)lds; float* q_s = k_s + 128; float* red = q_s + 128; float* red2 = red + 512; float* o_tile = red2 + 512;
    const bf16_t* qkv = (const bf16_t*)(p->ws + OFF_QKV);
    const float* garr = (const float*)(p->ws + OFF_G) + (size_t)bh * 4096; const float* barr = (const float*)(p->ws + OFF_BETA) + (size_t)bh * 4096;
    float S[32];
#pragma unroll
    for (int i = 0; i < 32; ++i) S[i] = 0.f;
    for (int n = 0; n < 64; ++n) {
        const size_t blk = (size_t)(bh * 64 + n) * 8192;
        const bf16_t* qb = qkv + blk; const bf16_t* kb = qkv + PLANE_ + blk; const bf16_t* vb = qkv + 2 * PLANE_ + blk;
        for (int c = 0; c < 64; ++c) {
            if (tid < 128) k_s[tid] = bf2f(kb[c * 128 + tid]); else if (tid < 256) q_s[tid - 128] = bf2f(qb[c * 128 + tid - 128]);
            const float vbe = bf2f(vb[e * 64 + c]); const float eg = __expf(garr[n * 64 + c]), beta = barr[n * 64 + c];
            __syncthreads();
            float part = 0.f;
#pragma unroll
            for (int i = 0; i < 32; ++i) part += k_s[32 * r + i] * S[i];
            red[r * 128 + e] = part;
            __syncthreads();
            const float kS = red[e] + red[128 + e] + red[256 + e] + red[384 + e];
            const float vn = vbe - beta * eg * kS;
            float po = 0.f;
#pragma unroll
            for (int i = 0; i < 32; ++i) { S[i] = eg * S[i] + k_s[32 * r + i] * vn; po += q_s[32 * r + i] * S[i]; }
            red2[r * 128 + e] = po;
            __syncthreads();
            if (r == 0) o_tile[c * 132 + e] = red2[e] + red2[128 + e] + red2[256 + e] + red2[384 + e];
        }
        __syncthreads();
        dn_out_tile(p, l, bh, n, o_tile);
        __syncthreads();
    }
}


DI bf16x8 ldfrag(const bf16_t* p) {
    const u32x2 lo = *(const u32x2*)p, hi = *(const u32x2*)(p + 16);
    u32x4 v; v[0] = lo[0]; v[1] = lo[1]; v[2] = hi[0]; v[3] = hi[1];
    return __builtin_bit_cast(bf16x8, v);
}
DI bf16x8 packfrag(const f32x4 a, const f32x4 b) {
    u32x4 v; v[0] = pkcvt(a[0], a[1]); v[1] = pkcvt(a[2], a[3]); v[2] = pkcvt(b[0], b[1]); v[3] = pkcvt(b[2], b[3]);
    return __builtin_bit_cast(bf16x8, v);
}

DI void dn_seq_chunked(CP p, int l, int bh, unsigned char* lds, unsigned long long& g_tsec) {
    const int tid = otid(), lane = tid & 63, w = tid >> 6, q = lane >> 4, fr = lane & 15;
    bf16_t* qt = (bf16_t*)lds;
    bf16_t* kt = (bf16_t*)(lds + 17408);
    bf16_t* kT = (bf16_t*)(lds + 34816);
    bf16_t* vT = (bf16_t*)(lds + 53248);
    bf16_t* ti = (bf16_t*)(lds + 71680);
    bf16_t* at = (bf16_t*)(lds + 80896);
    float* eg_s = (float*)(lds + 90112);
    float* bg_s = eg_s + 64;
    float* dl_s = eg_s + 128;
    float* misc = eg_s + 192;
    float* o_tile = (float*)(lds + 91136);
    const bf16_t* qkv = (const bf16_t*)(p->ws + OFF_QKV);
    const bf16_t* tab0 = (const bf16_t*)(p->ws + OFF_XB);
    const float* pe = (const float*)(p->ws + OFF_GC) + (size_t)bh * 4096 + (tid & 63); const float* pb = (const float*)(p->ws + OFF_BG) + (size_t)bh * 4096 + (tid & 63); const float* pd = (const float*)(p->ws + OFF_DL) + (size_t)bh * 4096 + (tid & 63);
    const bf16_t* pq = qkv + (size_t)bh * 64 * 8192 + (tid >> 4) * 128 + (tid & 15) * 8;
    const bf16_t* pk = qkv + PLANE_ + (size_t)bh * 64 * 8192 + (tid & 63) * 128 + (tid >> 6) * 8;
    const bf16_t* pv = qkv + 2 * PLANE_ + (size_t)bh * 64 * 8192 + (tid >> 3) * 64 + (tid & 7) * 8;
    const bf16_t* pt = tab0 + (size_t)bh * 64 * 8192 + tid * 8;
    u32x4 rq[2], rk[2], rv[2], rt, ra, cz0, cz1; float reg = 0.f, rbg = 0.f, rdl = 0.f;
    const bf16_t* zbase = (const bf16_t*)(p->ws + OFF_ZY) + ((size_t)(bh >> 3) * 4096 + (tid >> 3)) * 2048 + 1024 + (bh & 7) * 128 + (tid & 7) * 16;
#define DN_PREFETCH(nn) do { \
        rq[0] = *(const u32x4*)pq; rq[1] = *(const u32x4*)(pq + 4096); rk[0] = *(const u32x4*)pk; rk[1] = *(const u32x4*)(pk + 64); \
        rv[0] = *(const u32x4*)pv; rv[1] = *(const u32x4*)(pv + 4096); rt = *(const u32x4*)pt; ra = *(const u32x4*)(pt + 4096); \
        if (tid < 64) { reg = *pe; rbg = *pb; rdl = *pd; } \
        pq += 8192; pk += 8192; pv += 8192; pt += 8192; pe += 64; pb += 64; pd += 64; } while (0)
#define DN_STORE() do { \
        _Pragma("unroll") for (int i_ = 0; i_ < 2; ++i_) { const int e_ = tid + 512 * i_; \
            *(u32x4*)(qt + (e_ >> 4) * 136 + (e_ & 15) * 8) = rq[i_]; \
            *(u32x4*)(kt + (e_ & 63) * 136 + (e_ >> 6) * 8) = rk[i_]; \
            _Pragma("unroll") for (int j_ = 0; j_ < 8; ++j_) kT[((e_ >> 6) * 8 + j_) * 72 + (e_ & 63)] = (bf16_t)(rk[i_][j_ >> 1] >> ((j_ & 1) * 16)); \
            *(u32x4*)(vT + (e_ >> 3) * 72 + (e_ & 7) * 8) = rv[i_]; } \
        *(u32x4*)(ti + (tid >> 3) * 72 + (tid & 7) * 8) = rt; *(u32x4*)(at + (tid >> 3) * 72 + (tid & 7) * 8) = ra; \
        if (tid < 64) { eg_s[tid] = reg; bg_s[tid] = rbg; dl_s[tid] = rdl; if (tid == 63) misc[0] = reg; } } while (0)
    f32x4 S[8];
#pragma unroll
    for (int m = 0; m < 8; ++m) S[m] = (f32x4){0.f, 0.f, 0.f, 0.f};
    DN_PREFETCH(0); DN_STORE();
    __syncthreads();
    for (int n = 0; n < 64; ++n) {
#ifdef TS_SEC
        unsigned long long tsa_ = wall_clock64();
#define TSQ(id) do { const unsigned long long t_ = wall_clock64(); if (TS_SEC == (id) && l == 0) g_tsec += t_ - tsa_; tsa_ = t_; } while (0)
#else
#define TSQ(id) do {} while (0)
#endif
#define SB() __builtin_amdgcn_sched_barrier(0)
        bf16x8 Sb[4];
#pragma unroll
        for (int s = 0; s < 4; ++s) Sb[s] = packfrag(S[2 * s], S[2 * s + 1]);
        bf16x8 fa[2][4];
#pragma unroll
        for (int s = 0; s < 4; ++s) fa[0][s] = ldfrag(kt + fr * 136 + 32 * s + 4 * q);
        f32x4 eg4[4];
#pragma unroll
        for (int mm = 0; mm < 4; ++mm) eg4[mm] = *(const f32x4*)(eg_s + 16 * mm + 4 * q);
        SB();
        const bool pf_ = n + 1 < 64;
        TSQ(11);
        f32x4 P[4], Q[4];
        bf16x8 ft[6], fk[2][8];
        u32x2 vv[4]; f32x4 bg[4];
#pragma unroll
        for (int u = 0; u < 8; ++u) {
            if (u < 7) {
                const bf16_t* src = ((u + 1) & 1) ? qt : kt;
#pragma unroll
                for (int s = 0; s < 4; ++s) fa[(u + 1) & 1][s] = ldfrag(src + (16 * ((u + 1) >> 1) + fr) * 136 + 32 * s + 4 * q);
            } else {
                ft[0] = ldfrag(ti + fr * 72 + 4 * q); ft[1] = ldfrag(ti + (16 + fr) * 72 + 4 * q);
                ft[2] = ldfrag(ti + (32 + fr) * 72 + 4 * q); ft[3] = ldfrag(ti + (32 + fr) * 72 + 32 + 4 * q);
                ft[4] = ldfrag(ti + (48 + fr) * 72 + 4 * q); ft[5] = ldfrag(ti + (48 + fr) * 72 + 32 + 4 * q);
            }
            if (u == 0) { cz0 = *(const u32x4*)(zbase + (size_t)n * 64 * 2048); if (pf_) rq[0] = *(const u32x4*)pq; }
            if (u == 1) { cz1 = *(const u32x4*)(zbase + (size_t)n * 64 * 2048 + 8); if (pf_) rq[1] = *(const u32x4*)(pq + 4096); }
            if (u == 2 && pf_) rk[0] = *(const u32x4*)pk;
            if (u == 3 && pf_) rk[1] = *(const u32x4*)(pk + 64);
            if (u == 4 && pf_) rv[0] = *(const u32x4*)pv;
            if (u == 5 && pf_) rv[1] = *(const u32x4*)(pv + 4096);
            if (u == 6 && pf_) rt = *(const u32x4*)pt;
            if (u == 7 && pf_) { ra = *(const u32x4*)(pt + 4096); if (tid < 64) { reg = *pe; rbg = *pb; rdl = *pd; } pq += 8192; pk += 8192; pv += 8192; pt += 8192; pe += 64; pb += 64; pd += 64; }
            SB();
            f32x4 acc_ = (f32x4){0.f, 0.f, 0.f, 0.f};
#pragma unroll
            for (int s = 0; s < 4; ++s) acc_ = MFMA16(fa[u & 1][s], Sb[s], acc_);
            if (u & 1) Q[u >> 1] = acc_ * eg4[u >> 1]; else P[u >> 1] = acc_;
            SB();
        }
        TSQ(12);
#pragma unroll
        for (int mm = 0; mm < 4; ++mm) { vv[mm] = *(const u32x2*)(vT + (16 * w + fr) * 72 + 16 * mm + 4 * q); bg[mm] = *(const f32x4*)(bg_s + 16 * mm + 4 * q); }
        f32x4 R[4];
#pragma unroll
        for (int m = 0; m < 4; ++m) {
            R[m][0] = __uint_as_float(vv[m][0] << 16) - bg[m][0] * P[m][0]; R[m][1] = __uint_as_float(vv[m][0] & 0xFFFF0000u) - bg[m][1] * P[m][1];
            R[m][2] = __uint_as_float(vv[m][1] << 16) - bg[m][2] * P[m][2]; R[m][3] = __uint_as_float(vv[m][1] & 0xFFFF0000u) - bg[m][3] * P[m][3];
        }
        bf16x8 Rb[2]; Rb[0] = packfrag(R[0], R[1]); Rb[1] = packfrag(R[2], R[3]);
        bf16x8 fo[6];
        fo[0] = ldfrag(at + fr * 72 + 4 * q); fo[1] = ldfrag(at + (16 + fr) * 72 + 4 * q);
        fo[2] = ldfrag(at + (32 + fr) * 72 + 4 * q); fo[3] = ldfrag(at + (32 + fr) * 72 + 32 + 4 * q);
        fo[4] = ldfrag(at + (48 + fr) * 72 + 4 * q); fo[5] = ldfrag(at + (48 + fr) * 72 + 32 + 4 * q);
        SB();
        f32x4 vn[4];
        vn[0] = MFMA16(ft[0], Rb[0], ((f32x4){0.f, 0.f, 0.f, 0.f}));
        vn[1] = MFMA16(ft[1], Rb[0], ((f32x4){0.f, 0.f, 0.f, 0.f}));
        vn[2] = MFMA16(ft[2], Rb[0], ((f32x4){0.f, 0.f, 0.f, 0.f})); vn[2] = MFMA16(ft[3], Rb[1], vn[2]);
        vn[3] = MFMA16(ft[4], Rb[0], ((f32x4){0.f, 0.f, 0.f, 0.f})); vn[3] = MFMA16(ft[5], Rb[1], vn[3]);
        SB();
        bf16x8 Vb[2]; Vb[0] = packfrag(vn[0], vn[1]); Vb[1] = packfrag(vn[2], vn[3]);
#pragma unroll
        for (int mm = 0; mm < 4; ++mm) { fk[0][2 * mm] = ldfrag(kT + (16 * mm + fr) * 72 + 4 * q); fk[0][2 * mm + 1] = ldfrag(kT + (16 * mm + fr) * 72 + 32 + 4 * q); }
        SB();
        {
            f32x4 o0 = Q[0], o1 = Q[1], o2 = Q[2], o3 = Q[3];
            o0 = MFMA16(fo[0], Vb[0], o0); o1 = MFMA16(fo[1], Vb[0], o1);
            o2 = MFMA16(fo[2], Vb[0], o2); o3 = MFMA16(fo[4], Vb[0], o3);
            o2 = MFMA16(fo[3], Vb[1], o2); o3 = MFMA16(fo[5], Vb[1], o3);
            SB();
#pragma unroll
            for (int i = 0; i < 4; ++i) { o_tile[(4 * q + i) * 132 + 16 * w + fr] = o0[i]; o_tile[(16 + 4 * q + i) * 132 + 16 * w + fr] = o1[i]; o_tile[(32 + 4 * q + i) * 132 + 16 * w + fr] = o2[i]; o_tile[(48 + 4 * q + i) * 132 + 16 * w + fr] = o3[i]; }
        }
        TSQ(13);
        const float egl = misc[0];
#pragma unroll
        for (int m = 0; m < 4; ++m) { const f32x4 dl = *(const f32x4*)(dl_s + 16 * m + 4 * q); vn[m] = vn[m] * dl; }
        bf16x8 Vd[2]; Vd[0] = packfrag(vn[0], vn[1]); Vd[1] = packfrag(vn[2], vn[3]);
#pragma unroll
        for (int mm = 0; mm < 4; ++mm) { fk[1][2 * mm] = ldfrag(kT + (64 + 16 * mm + fr) * 72 + 4 * q); fk[1][2 * mm + 1] = ldfrag(kT + (64 + 16 * mm + fr) * 72 + 32 + 4 * q); }
        SB();
#pragma unroll
        for (int mm = 0; mm < 4; ++mm) { f32x4 a_ = S[mm] * egl; a_ = MFMA16(fk[0][2 * mm], Vd[0], a_); a_ = MFMA16(fk[0][2 * mm + 1], Vd[1], a_); S[mm] = a_; }
        SB();
#pragma unroll
        for (int mm = 0; mm < 4; ++mm) { f32x4 a_ = S[4 + mm] * egl; a_ = MFMA16(fk[1][2 * mm], Vd[0], a_); a_ = MFMA16(fk[1][2 * mm + 1], Vd[1], a_); S[4 + mm] = a_; }
#undef SB
        TSQ(14);
        __syncthreads();
        TSQ(15);
        dn_out_tile(p, l, bh, n, o_tile, true, cz0, cz1);
        TSQ(16);
        if (n + 1 < 64) DN_STORE();
        TSQ(17);
        __syncthreads();
        TSQ(18);
    }
#undef DN_PREFETCH
#undef DN_STORE
#undef TSQ
}

DI void sub_barrier(unsigned* ctr, unsigned nblocks) {
    __syncthreads();
    if (threadIdx.x == 0) {
        __threadfence();
        __hip_atomic_fetch_add(ctr, 1u, __ATOMIC_RELAXED, __HIP_MEMORY_SCOPE_AGENT);
        { int bo_ = 1; while (__hip_atomic_load(ctr, __ATOMIC_RELAXED, __HIP_MEMORY_SCOPE_AGENT) < nblocks) { for (int k_ = 0; k_ < bo_; ++k_) __builtin_amdgcn_s_sleep(8); if (bo_ < 4) bo_ *= 2; } }
        __threadfence();
    }
    __syncthreads();
}

DI void run_phase(CP p, int ph, unsigned char* shm, unsigned long long& g_tsec) {
    unsigned char* ws = p->ws;
#ifndef PHM
#define PHM 63
#endif
    if (ph == 0) { if (blockIdx.x == 0) { ((unsigned*)(ws + OFF_CTR))[threadIdx.x] = 0u; ((unsigned*)(ws + OFF_CTR))[512 + threadIdx.x] = 0u; }
        if (PHM & 1) prep_phase(p, shm); rownorm_phase(p->x, (bf16_t*)(ws + OFF_XB), (float*)(ws + OFF_RSTD), nullptr, nullptr); return; }
    const int l = (ph - 1) / 5, sub = (ph - 1) % 5;
    if (sub == 0) { if (PHM & 2) {
        pg8::Gemm g; g.A = (const bf16_t*)(ws + OFF_XB); g.Bt = (const bf16_t*)(ws + OFF_WIN) + (size_t)l * NPAD_ * 1024; g.M = M_; g.N = NPAD_; g.K = 1024;
        pg8::StaticOrder S; S.init(M_, NPAD_, (int)gridDim.x, (int)blockIdx.x);
        EpiIn E; E.rstd = (const float*)(ws + OFF_RSTD); E.ws = ws;
        pg8::gemm_phase<EpiIn, pg8::StaticOrder, false>((PG8_LAS unsigned char*)shm, g, S, E, nullptr); }
    } else if (sub == 1) { if (PHM & 4) {
        dn_local_phase(p, l, shm, g_tsec);
        }
    } else if (sub == 2) { if (PHM & 8) {
        #ifdef DN_NAIVE
        if (blockIdx.x < 64) dn_seq_naive(p, l, blockIdx.x, shm);
#else
        if (blockIdx.x < 64) dn_seq_chunked(p, l, blockIdx.x, shm, g_tsec);
#endif
        else {
            lru_phase(p, l, 1, blockIdx.x - 64, gridDim.x - 64, shm);
            sub_barrier((unsigned*)(ws + OFF_CTR) + 16 * l, gridDim.x - 64);
            lru_phase(p, l, 2, blockIdx.x - 64, gridDim.x - 64, shm);
        } }
    } else if (sub == 3) { if (PHM & 16) {
        pg8::Gemm g; g.A = (const bf16_t*)(ws + OFF_ZY); g.Bt = (const bf16_t*)(ws + OFF_WOUT) + (size_t)l * 1024 * 2048; g.M = M_; g.N = 1024; g.K = 2048;
        pg8::StaticOrder S; S.init(M_, 1024, (int)gridDim.x, (int)blockIdx.x);
        EpiOut E; E.res = l == 0 ? p->x : p->out; E.out = p->out;
        pg8::gemm_phase<EpiOut, pg8::StaticOrder, false>((PG8_LAS unsigned char*)shm, g, S, E, nullptr); }
    } else {
        if (l == 0) rownorm_phase(p->out, (bf16_t*)(ws + OFF_XB), (float*)(ws + OFF_RSTD), nullptr, nullptr);
        else rownorm_phase(p->out, nullptr, nullptr, p->final_norm_w, p->out);
    }
}

__global__ void __launch_bounds__(512, 2) hymba_mega(Params p) {
    extern __shared__ __attribute__((aligned(16))) unsigned char shm[];
    cg::grid_group grid = cg::this_grid();
    unsigned long long g_tsec = 0;
#ifdef TS_PHASE
    unsigned long long ts0 = 0, ts1 = 0;
#endif
    unsigned* const bar_ = (unsigned*)(p.ws + OFF_CTR);
    volatile unsigned* const st_ = (volatile unsigned*)(shm + 131072);
    if (threadIdx.x == 0 && p.ph_lo == 0) bar_[1024 + blockIdx.x] = (unsigned)__builtin_amdgcn_s_getreg((3 << 11) | 20) & 0x7u;
    unsigned cseam = 0;
    for (int ph = p.ph_lo; ph < p.ph_hi; ++ph) {
        if (ph > p.ph_lo) {
            if (ph == p.ph_lo + 1 || p.ph_lo != 0) {
                grid.sync();
                if (threadIdx.x == 0 && p.ph_lo == 0) {
                    const unsigned x_ = (unsigned)__builtin_amdgcn_s_getreg((3 << 11) | 20) & 0x7u; unsigned mine_ = 0, mask_ = 0;
                    for (unsigned i_ = 0; i_ < gridDim.x; ++i_) { const unsigned v_ = bar_[1024 + i_]; mine_ += (v_ == x_) ? 1u : 0u; mask_ |= 1u << v_; }
                    st_[0] = mine_; st_[1] = (unsigned)__builtin_popcount(mask_);
                }
                __syncthreads();
            } else {
                ++cseam;
                asm volatile("s_waitcnt vmcnt(0)" ::: "memory");
                __syncthreads();
                if (threadIdx.x == 0) {
                    const unsigned x_ = (unsigned)__builtin_amdgcn_s_getreg((3 << 11) | 20) & 0x7u, nloc_ = st_[0], nx_ = st_[1];
                    unsigned* top_ = bar_ + 64;
                    if (__hip_atomic_fetch_add(bar_ + 128 + 64 * x_, 1u, __ATOMIC_RELAXED, __HIP_MEMORY_SCOPE_AGENT) + 1u == nloc_ * cseam) {
                        __builtin_amdgcn_fence(__ATOMIC_RELEASE, "agent");
                        asm volatile("s_waitcnt vmcnt(0)" ::: "memory");
                        __hip_atomic_fetch_add(top_, 1u, __ATOMIC_RELAXED, __HIP_MEMORY_SCOPE_AGENT);
                    }
                    { int bo_ = 1; unsigned spins_ = 0; const unsigned target_ = nx_ * cseam;
                      while (__hip_atomic_load(top_, __ATOMIC_RELAXED, __HIP_MEMORY_SCOPE_AGENT) < target_ && ++spins_ < (1u << 22)) { for (int k_ = 0; k_ < bo_; ++k_) __builtin_amdgcn_s_sleep(8); if (bo_ < 4) bo_ *= 2; } }
                    __builtin_amdgcn_fence(__ATOMIC_ACQUIRE, "agent");
                    asm volatile("s_waitcnt vmcnt(0)" ::: "memory");
                }
                __syncthreads();
            }
        }
#ifdef TS_PHASE
        if (ph == TS_PHASE) ts0 = wall_clock64();
#endif
        { CP pc = (CP)__builtin_amdgcn_kernarg_segment_ptr(); asm volatile("" : "+s"(pc)); run_phase(pc, ph, shm, g_tsec); }
#ifdef TS_PHASE
        if (ph == TS_PHASE) ts1 = wall_clock64();
#endif
    }
#ifdef TS_PHASE
    grid.sync();
    if (blockIdx.x == TS_BLOCK) {
#ifdef TS_SEC
        const long long K = (long long)g_tsec / 2;
#else
        const long long K = (long long)(ts1 - ts0) / 2;
#endif
        for (long long i = threadIdx.x; i < K && i < 500000; i += 512) p.out[(size_t)i * 64] += 0.08f; }
#endif
}

extern "C" void kernel_launch(void* const* d_in, const int* in_sizes, int n_in, void* d_out, int out_size, void* d_ws, size_t ws_size, hipStream_t stream) {
    static int grid = 0;
    if (grid == 0) {
        if (n_in != 17 || in_sizes[0] != M_ * 1024 || out_size != M_ * 1024 || ws_size < WS_END) {
            fprintf(stderr, "kernel_launch: unexpected shapes (n_in %d, in0 %d, out %d, ws %zu, need %zu); nothing launched\n", n_in, n_in > 0 ? in_sizes[0] : -1, out_size, ws_size, (size_t)WS_END);
            grid = -1; return;
        }
        if (hipFuncSetAttribute((const void*)hymba_mega, hipFuncAttributeMaxDynamicSharedMemorySize, LDS_BYTES) != hipSuccess) { fprintf(stderr, "kernel_launch: hipFuncSetAttribute failed\n"); grid = -1; return; }
        int dev = 0, cus = 0, per_cu = 0;
        hipGetDevice(&dev); hipDeviceGetAttribute(&cus, hipDeviceAttributeMultiprocessorCount, dev);
        if (hipOccupancyMaxActiveBlocksPerMultiprocessor(&per_cu, (const void*)hymba_mega, 512, LDS_BYTES) != hipSuccess || per_cu < 1) { fprintf(stderr, "kernel_launch: occupancy query says %d blocks per CU\n", per_cu); per_cu = 1; }
        (void)hipGetLastError();
        grid = cus;
        fprintf(stderr, "kernel_launch: grid %d (cus %d, per_cu %d)\n", grid, cus, per_cu);
    }
    if (grid < 0) return;
    Params p{};
    const float** pp = (const float**)&p;
    for (int i = 0; i < 17; ++i) pp[i] = (const float*)d_in[i];
    p.out = (float*)d_out; p.ws = (unsigned char*)d_ws;
#if MK_SINGLE
    p.ph_lo = 0; p.ph_hi = N_PHASES;
    void* args[] = {&p};
    hipError_t e = hipLaunchCooperativeKernel((const void*)hymba_mega, dim3(grid), dim3(512), args, LDS_BYTES, stream);
    if (e != hipSuccess) fprintf(stderr, "kernel_launch: cooperative launch failed: %s (grid %d)\n", hipGetErrorString(e), grid);
#else
    for (int ph = 0; ph < N_PHASES; ++ph) {
        p.ph_lo = ph; p.ph_hi = ph + 1;
        hipLaunchKernelGGL(hymba_mega, dim3(grid), dim3(512), LDS_BYTES, stream, p);
    }
#endif
}
```
